# Optimizing an MI355X kernel written in HIP

```python
import math
import jax
import jax.numpy as jnp
from jax import lax
import numpy as np

D_MODEL = 1024
BATCH = 16
SEQ = 4096
DEPTH = 1

N_HEADS_DIL = 6
N_HEADS_MOBA = 6
N_HEADS_MEM = 4
N_HEADS_MIX = N_HEADS_DIL + N_HEADS_MOBA + N_HEADS_MEM
HEAD_DIM = D_MODEL // N_HEADS_MIX
W_DIL = N_HEADS_DIL * HEAD_DIM
W_MOBA = N_HEADS_MOBA * HEAD_DIM
W_MEM = N_HEADS_MEM * HEAD_DIM
MIX_WIDTH = W_DIL + W_MOBA + W_MEM
IN_WIDTH = 3 * W_DIL + 3 * W_MOBA + W_MEM
DIL_CONFIGS = ((128, 1), (512, 4), (2048, 16))
BAND_BLOCK = 128
MOBA_BLOCK = 256
MOBA_TOPK = 3
MOBA_QBLOCK = 128
MEM_LEN = 256
PEER_HEADS = 8
PEER_NKEYS = 128
PEER_EXPERTS = PEER_NKEYS * PEER_NKEYS
PEER_TOPK = 16
PEER_DKEY = 256
PEER_CHUNK = 128
RMS_EPS = 1e-6
NEG_INF = -1e30

kernel_name = 'hymba_style_dilated_moba_mem_peer_layer'


def rms_norm(a, g):
    af = a.astype(jnp.float32)
    y = af * lax.rsqrt(jnp.mean(af * af, axis=-1, keepdims=True) + RMS_EPS)
    return (y * g.astype(jnp.float32)).astype(a.dtype)


def split_heads(a, n_heads):
    b, s, _ = a.shape
    return a.reshape(b, s, n_heads, HEAD_DIM).transpose(0, 2, 1, 3)


def merge_heads(a):
    b, h, s, dh = a.shape
    return a.transpose(0, 2, 1, 3).reshape(b, s, h * dh)


def alibi_slopes(n):
    return jnp.exp2(-8.0 * jnp.arange(1, n + 1, dtype=jnp.float32) / n)


def dilated_branch(q, k, v, slopes, window, dilation):
    B, H, S, Dh = q.shape
    L = S // dilation
    n_blk = -(-L // BAND_BLOCK)
    Lp = n_blk * BAND_BLOCK
    reach = window // dilation

    def split(a):
        a = a.reshape(B, H, L, dilation, Dh).transpose(0, 1, 3, 2, 4)
        a = jnp.pad(a, ((0, 0), (0, 0), (0, 0), (0, Lp - L), (0, 0)))
        return a.reshape(B, H, dilation, n_blk, BAND_BLOCK, Dh)

    def with_prev(a):
        prev = jnp.pad(a, ((0, 0), (0, 0), (0, 0), (1, 0), (0, 0), (0, 0)))[:, :, :, :-1]
        return jnp.concatenate([prev, a], axis=4)

    qb = split(q)
    kc = with_prev(split(k))
    vc = with_prev(split(v))
    s = jnp.einsum('bhrnqd,bhrnkd->bhrnqk', qb, kc).astype(jnp.float32) * (1.0 / math.sqrt(Dh))
    ql = jnp.arange(BAND_BLOCK)[:, None]
    kl = jnp.arange(2 * BAND_BLOCK)[None, :]
    delta = BAND_BLOCK + ql - kl
    blk = jnp.arange(n_blk)[:, None, None]
    valid = (delta >= 0) & (delta <= reach) & (blk * BAND_BLOCK - BAND_BLOCK + kl[None] >= 0)
    bias = -slopes[:, None, None, None, None] * (delta * dilation).astype(jnp.float32)
    s = jnp.where(valid, s + bias, NEG_INF)
    m = jnp.max(s, axis=-1, keepdims=True)
    p = jnp.exp(s - m)
    den = jnp.sum(p, axis=-1, keepdims=True)
    lse = m[..., 0] + jnp.log(den[..., 0])
    o = jnp.einsum('bhrnqk,bhrnkd->bhrnqd', p.astype(v.dtype), vc) / den.astype(v.dtype)

    def merge(a):
        tail = a.shape[5:]
        a = a.reshape((B, H, dilation, Lp) + tail)[:, :, :, :L]
        a = jnp.moveaxis(a, 2, 3)
        return a.reshape((B, H, S) + tail)

    return merge(o), merge(lse)


def dilated_mixture(q, k, v, slopes):
    outs, lses = [], []
    for window, dilation in DIL_CONFIGS:
        o, l = dilated_branch(q, k, v, slopes, window, dilation)
        outs.append(o)
        lses.append(l)
    wts = jax.nn.softmax(jnp.stack(lses, axis=0), axis=0).astype(q.dtype)
    return jnp.einsum('cbhs,cbhsd->bhsd', wts, jnp.stack(outs, axis=0))


def moba_attention(q, k, v, slopes):
    B, H, S, Dh = q.shape
    n_blk = -(-S // MOBA_BLOCK)
    Sp = n_blk * MOBA_BLOCK
    pad = ((0, 0), (0, 0), (0, Sp - S), (0, 0))
    kb = jnp.pad(k, pad).reshape(B, H, n_blk, MOBA_BLOCK, Dh)
    vb = jnp.pad(v, pad).reshape(B, H, n_blk, MOBA_BLOCK, Dh)
    k_mean = jnp.mean(kb.astype(jnp.float32), axis=3).astype(k.dtype)
    gate = jnp.einsum('bhsd,bhnd->bhsn', q, k_mean).astype(jnp.float32)
    n_past = jnp.arange(S) // MOBA_BLOCK
    past = jnp.arange(n_blk)[None, :] < n_past[:, None]
    gate = jnp.where(past, gate, NEG_INF)
    k_sel = min(MOBA_TOPK, n_blk)
    _, sel = lax.top_k(gate, k_sel)

    n_qb = S // MOBA_QBLOCK
    qq = q.reshape(B, H, n_qb, MOBA_QBLOCK, Dh).transpose(0, 2, 1, 3, 4).reshape(B * n_qb, H, MOBA_QBLOCK, Dh)
    ss = sel.reshape(B, H, n_qb, MOBA_QBLOCK, k_sel).transpose(0, 2, 1, 3, 4).reshape(B * n_qb, H, MOBA_QBLOCK, k_sel)
    b_ids = jnp.repeat(jnp.arange(B, dtype=jnp.int32), n_qb)
    n_ids = jnp.tile(jnp.arange(n_qb, dtype=jnp.int32), B)
    head = jnp.arange(H)[:, None, None]
    scale = 1.0 / math.sqrt(Dh)
    n_sel_keys = k_sel * MOBA_BLOCK

    def step(args):
        q_blk, sel_blk, b, n = args
        kb_b = lax.dynamic_index_in_dim(kb, b, axis=0, keepdims=False)
        vb_b = lax.dynamic_index_in_dim(vb, b, axis=0, keepdims=False)
        t_q = n * MOBA_QBLOCK + jnp.arange(MOBA_QBLOCK)
        k_g = kb_b[head, sel_blk]
        v_g = vb_b[head, sel_blk]
        s_sel = jnp.einsum('hqd,hqjkd->hqjk', q_blk, k_g).astype(jnp.float32) * scale
        s_pos = sel_blk[..., None] * MOBA_BLOCK + jnp.arange(MOBA_BLOCK)
        ok = jnp.arange(k_sel)[None, :] < (t_q // MOBA_BLOCK)[:, None]
        dist_sel = (t_q[None, :, None, None] - s_pos).astype(jnp.float32)
        s_sel = jnp.where(ok[None, :, :, None], s_sel - slopes[:, None, None, None] * dist_sel, NEG_INF)
        own = (n * MOBA_QBLOCK) // MOBA_BLOCK
        k_own = lax.dynamic_index_in_dim(kb_b, own, axis=1, keepdims=False)
        v_own = lax.dynamic_index_in_dim(vb_b, own, axis=1, keepdims=False)
        o_pos = own * MOBA_BLOCK + jnp.arange(MOBA_BLOCK)
        dist_own = t_q[:, None] - o_pos[None, :]
        s_own = jnp.einsum('hqd,hkd->hqk', q_blk, k_own).astype(jnp.float32) * scale
        s_own = jnp.where(dist_own >= 0, s_own - slopes[:, None, None] * dist_own.astype(jnp.float32), NEG_INF)
        s_all = jnp.concatenate([s_sel.reshape(H, MOBA_QBLOCK, n_sel_keys), s_own], axis=-1)
        p = jax.nn.softmax(s_all, axis=-1).astype(v.dtype)
        p_sel = p[..., :n_sel_keys].reshape(H, MOBA_QBLOCK, k_sel, MOBA_BLOCK)
        p_own = p[..., n_sel_keys:]
        return (jnp.einsum('hqjk,hqjkd->hqd', p_sel, v_g)
                + jnp.einsum('hqk,hkd->hqd', p_own, v_own))

    out = lax.map(step, (qq, ss, b_ids, n_ids))
    return out.reshape(B, n_qb, H, MOBA_QBLOCK, Dh).transpose(0, 2, 1, 3, 4).reshape(B, H, S, Dh)


def memory_attention(q, k, v):
    s = jnp.einsum('bhsd,bhmd->bhsm', q, k).astype(jnp.float32) * (1.0 / math.sqrt(q.shape[-1]))
    p = jax.nn.softmax(s, axis=-1).astype(v.dtype)
    return jnp.einsum('bhsm,bhmd->bhsd', p, v)


def peer_ffn(h, w_q, sub1, sub2, u, v):
    B, S, D = h.shape
    half = PEER_DKEY // 2
    qry = (h @ w_q).reshape(B, S, PEER_HEADS, PEER_DKEY)
    s1 = jnp.einsum('bshd,hkd->bshk', qry[..., :half], sub1).astype(jnp.float32)
    s2 = jnp.einsum('bshd,hkd->bshk', qry[..., half:], sub2).astype(jnp.float32)
    v1, i1 = lax.top_k(s1, PEER_TOPK)
    v2, i2 = lax.top_k(s2, PEER_TOPK)
    cand = (v1[..., :, None] + v2[..., None, :]).reshape(B, S, PEER_HEADS, PEER_TOPK * PEER_TOPK)
    cand_idx = (i1[..., :, None] * PEER_NKEYS + i2[..., None, :]).reshape(B, S, PEER_HEADS, PEER_TOPK * PEER_TOPK)
    top_s, pos = lax.top_k(cand, PEER_TOPK)
    expert = jnp.take_along_axis(cand_idx, pos, axis=-1)
    gate = jax.nn.softmax(top_s, axis=-1)
    T = B * S
    E = PEER_HEADS * PEER_TOPK
    n_chunk = T // PEER_CHUNK
    hx = h.reshape(n_chunk, PEER_CHUNK, D)
    ex = expert.reshape(n_chunk, PEER_CHUNK, E)
    gx = gate.reshape(n_chunk, PEER_CHUNK, E).astype(h.dtype)

    def step(args):
        x_c, e_c, g_c = args
        a = jnp.einsum('cd,ced->ce', x_c, u[e_c])
        w = jax.nn.gelu(a.astype(jnp.float32), approximate=False).astype(x_c.dtype) * g_c
        return jnp.einsum('ce,ced->cd', w, v[e_c])

    return lax.map(step, (hx, ex, gx)).reshape(B, S, D)


def hybrid_layer(x, mem, g_mix, w_in, qg_dil, kg_dil, qg_moba, kg_moba, qg_mem, kg_mem, g_memtok, w_mem_kv,
                 og_dil, og_moba, og_mem, w_out, g_ffn, w_peer_q, sub1, sub2, peer_u, peer_v):
    slopes = alibi_slopes(N_HEADS_DIL + N_HEADS_MOBA)
    sl_dil, sl_moba = slopes[0::2], slopes[1::2]
    hn = rms_norm(x, g_mix)
    proj = hn @ w_in
    cuts = [W_DIL, 2 * W_DIL, 3 * W_DIL, 3 * W_DIL + W_MOBA, 3 * W_DIL + 2 * W_MOBA, 3 * W_DIL + 3 * W_MOBA]
    q_d, k_d, v_d, q_b, k_b, v_b, q_m = jnp.split(proj, cuts, axis=-1)
    q_d = rms_norm(split_heads(q_d, N_HEADS_DIL), qg_dil)
    k_d = rms_norm(split_heads(k_d, N_HEADS_DIL), kg_dil)
    o_dil = dilated_mixture(q_d, k_d, split_heads(v_d, N_HEADS_DIL), sl_dil)
    q_b = rms_norm(split_heads(q_b, N_HEADS_MOBA), qg_moba)
    k_b = rms_norm(split_heads(k_b, N_HEADS_MOBA), kg_moba)
    o_moba = moba_attention(q_b, k_b, split_heads(v_b, N_HEADS_MOBA), sl_moba)
    kv = rms_norm(mem, g_memtok) @ w_mem_kv
    k_m, v_m = jnp.split(kv, 2, axis=-1)
    q_m = rms_norm(split_heads(q_m, N_HEADS_MEM), qg_mem)
    k_m = rms_norm(split_heads(k_m, N_HEADS_MEM), kg_mem)
    o_mem = memory_attention(q_m, k_m, split_heads(v_m, N_HEADS_MEM))
    y = jnp.concatenate([rms_norm(merge_heads(o_dil), og_dil),
                         rms_norm(merge_heads(o_moba), og_moba),
                         rms_norm(merge_heads(o_mem), og_mem)], axis=-1) @ w_out
    x = x + y
    x = x + peer_ffn(rms_norm(x, g_ffn), w_peer_q, sub1, sub2, peer_u, peer_v)
    return x


def setup_inputs(seed: int = 0) -> dict:
    key = jax.random.key(seed)
    ks = jax.random.split(key, 24)

    def nrm(k, shape, scale):
        return jax.random.normal(k, shape, jnp.float32) * scale

    def gain(k, n):
        return 1.0 + 0.02 * jax.random.normal(k, (DEPTH, n), jnp.float32)

    return {
        'x': nrm(ks[0], (BATCH, SEQ, D_MODEL), 1.0),
        'mem': nrm(ks[1], (BATCH, MEM_LEN, D_MODEL), 1.0),
        'g_mix': gain(ks[2], D_MODEL),
        'w_in': nrm(ks[3], (DEPTH, D_MODEL, IN_WIDTH), D_MODEL ** -0.5),
        'qg_dil': gain(ks[4], HEAD_DIM),
        'kg_dil': gain(ks[5], HEAD_DIM),
        'qg_moba': gain(ks[6], HEAD_DIM),
        'kg_moba': gain(ks[7], HEAD_DIM),
        'qg_mem': gain(ks[8], HEAD_DIM),
        'kg_mem': gain(ks[9], HEAD_DIM),
        'g_memtok': gain(ks[10], D_MODEL),
        'w_mem_kv': nrm(ks[11], (DEPTH, D_MODEL, 2 * W_MEM), D_MODEL ** -0.5),
        'og_dil': gain(ks[12], W_DIL),
        'og_moba': gain(ks[13], W_MOBA),
        'og_mem': gain(ks[14], W_MEM),
        'w_out': nrm(ks[15], (DEPTH, MIX_WIDTH, D_MODEL), MIX_WIDTH ** -0.5),
        'g_ffn': gain(ks[16], D_MODEL),
        'w_peer_q': nrm(ks[17], (DEPTH, D_MODEL, PEER_HEADS * PEER_DKEY), D_MODEL ** -0.5),
        'peer_subkeys_1': nrm(ks[18], (DEPTH, PEER_HEADS, PEER_NKEYS, PEER_DKEY // 2), (PEER_DKEY // 2) ** -0.5),
        'peer_subkeys_2': nrm(ks[19], (DEPTH, PEER_HEADS, PEER_NKEYS, PEER_DKEY // 2), (PEER_DKEY // 2) ** -0.5),
        'peer_u': nrm(ks[20], (DEPTH, PEER_EXPERTS, D_MODEL), D_MODEL ** -0.5),
        'peer_v': nrm(ks[21], (DEPTH, PEER_EXPERTS, D_MODEL), PEER_HEADS ** -0.5),
    }


def reference(x, mem, g_mix, w_in, qg_dil, kg_dil, qg_moba, kg_moba, qg_mem, kg_mem, g_memtok, w_mem_kv,
              og_dil, og_moba, og_mem, w_out, g_ffn, w_peer_q, peer_subkeys_1, peer_subkeys_2, peer_u, peer_v):
    h = x
    for layer in range(DEPTH):
        h = hybrid_layer(h, mem, g_mix[layer], w_in[layer], qg_dil[layer], kg_dil[layer], qg_moba[layer],
                         kg_moba[layer], qg_mem[layer], kg_mem[layer], g_memtok[layer], w_mem_kv[layer],
                         og_dil[layer], og_moba[layer], og_mem[layer], w_out[layer], g_ffn[layer],
                         w_peer_q[layer], peer_subkeys_1[layer], peer_subkeys_2[layer], peer_u[layer],
                         peer_v[layer])
    return h
```

```cpp
#include <hip/hip_runtime.h>
#include <hip/hip_cooperative_groups.h>
#include <stdint.h>
#include <stdio.h>
namespace cg = cooperative_groups;

#ifndef DUP_PHASE
#define DUP_PHASE -1
#endif
#ifndef DUP_PARTS
#define DUP_PARTS 7
#endif
#ifndef PROBE_TYPE
#define PROBE_TYPE 0
#endif
#ifndef PP_OUT
#define PP_OUT 1
#endif
#ifndef PP_N2
#define PP_N2 1
#endif
#ifndef PP_PQ
#define PP_PQ 1
#endif

typedef unsigned short bf16_t;
typedef __attribute__((ext_vector_type(8))) short bf16x8;
typedef __attribute__((ext_vector_type(16))) float f32x16;
typedef __attribute__((ext_vector_type(4))) unsigned u32x4;
typedef __attribute__((ext_vector_type(2))) unsigned u32x2;
typedef __attribute__((ext_vector_type(4))) short s16x4;
#define DI __device__ __forceinline__
#define LDSP __attribute__((address_space(3)))

#define T_TOK 65536
#define SEQ 4096
#define NB 16
#define DM 1024
#define INW 2560
#define NGRP 40
#define MEMLEN 256
#define NTHREADS 512
#define WPB 8
#define STAGE_BYTES 49152
#define RING_BYTES (3 * STAGE_BYTES)
#define LDS_BYTES 163840

struct Params {
  const float *x, *mem, *g_mix, *w_in, *qg_dil, *kg_dil, *qg_moba, *kg_moba, *qg_mem, *kg_mem, *g_memtok, *w_mem_kv,
      *og_dil, *og_moba, *og_mem, *w_out, *g_ffn, *w_peer_q, *sub1, *sub2, *peer_u, *peer_v;
  float* out;
  unsigned* bar;
  bf16_t *HN;
  bf16_t *QKV;
  bf16_t *MEMN;
  bf16_t *KVM;
  bf16_t *WinT, *WoutT, *WqT, *WmkvT;
  bf16_t *SUB1, *SUB2;
  uint8_t *U8s, *V8s;
  float *SU, *SV;
  float *SW;
  uint8_t *X8;
  float *SX;
  float *PP;
  float *KMEAN;
  bf16_t *DILO;
  float *LSE2;
  unsigned short *PIDX;
  float *PGATE;
};

typedef const __attribute__((address_space(4))) Params* KernargPtr;
DI KernargPtr karg() {
#if defined(__HIP_DEVICE_COMPILE__)
  KernargPtr q = (KernargPtr)__builtin_amdgcn_kernarg_segment_ptr();
  asm volatile("" : "+s"(q));
  return q;
#else
  return nullptr;
#endif
}
DI float bf2f(bf16_t v) { return __uint_as_float(((unsigned)v) << 16); }
typedef __attribute__((ext_vector_type(2))) __bf16 bf16v2;
typedef __attribute__((ext_vector_type(2))) float f32x2;
DI unsigned pack2(float a, float b) { f32x2 v = {a, b}; return __builtin_bit_cast(unsigned, __builtin_convertvector(v, bf16v2)); }
template <int CTRL>
DI float dppf(float v) { return __int_as_float(__builtin_amdgcn_update_dpp(0, __float_as_int(v), CTRL, 0xf, 0xf, true)); }
DI float sum8(float v) { v += dppf<0xB1>(v); v += dppf<0x4E>(v); v += dppf<0x141>(v); return v; }
DI float sum16(float v) { v = sum8(v); v += dppf<0x140>(v); return v; }
DI float max16(float v) { v = fmaxf(v, dppf<0xB1>(v)); v = fmaxf(v, dppf<0x4E>(v)); v = fmaxf(v, dppf<0x141>(v)); v = fmaxf(v, dppf<0x140>(v)); return v; }
DI float sum32(float v) {
  v = sum16(v);
  auto rr = __builtin_amdgcn_permlane16_swap(__float_as_uint(v), __float_as_uint(v), false, false);
  return __uint_as_float(rr[0]) + __uint_as_float(rr[1]);
}
DI float max32(float v) {
  v = max16(v);
  auto rr = __builtin_amdgcn_permlane16_swap(__float_as_uint(v), __float_as_uint(v), false, false);
  return fmaxf(__uint_as_float(rr[0]), __uint_as_float(rr[1]));
}
DI float wave_sum(float v) {
  v = sum32(v);
  auto rr = __builtin_amdgcn_permlane32_swap(__float_as_uint(v), __float_as_uint(v), false, false);
  return __uint_as_float(rr[0]) + __uint_as_float(rr[1]);
}
DI float wave_max(float v) {
  v = max32(v);
  auto rr = __builtin_amdgcn_permlane32_swap(__float_as_uint(v), __float_as_uint(v), false, false);
  return fmaxf(__uint_as_float(rr[0]), __uint_as_float(rr[1]));
}
DI int crow(int i, int h) { return (i & 3) + 8 * (i >> 2) + 4 * h; }

DI void rmsnorm_rows(const int tid_, const float* __restrict__ src, const float* __restrict__ g, bf16_t* __restrict__ dst, int rows, int gw, int nw) {
  const int lane = tid_ & 63;
  for (int row = gw; row < rows; row += nw) {
    const float4* s4 = (const float4*)(src + (size_t)row * DM);
    float4 v[4];
    float ss = 0.f;
#pragma unroll
    for (int i = 0; i < 4; ++i) { v[i] = s4[lane + 64 * i]; ss += v[i].x * v[i].x + v[i].y * v[i].y + v[i].z * v[i].z + v[i].w * v[i].w; }
    ss = wave_sum(ss);
    const float rinv = rsqrtf(ss * (1.0f / DM) + 1e-6f);
#pragma unroll
    for (int i = 0; i < 4; ++i) {
      const float4 gg = ((const float4*)g)[lane + 64 * i];
      uint2 o;
      o.x = pack2(v[i].x * rinv * gg.x, v[i].y * rinv * gg.y);
      o.y = pack2(v[i].z * rinv * gg.z, v[i].w * rinv * gg.w);
      ((uint2*)(dst + (size_t)row * DM))[lane + 64 * i] = o;
    }
  }
}
DI void transpose_w(const float* __restrict__ W, bf16_t* __restrict__ Wt, int K, int N, int gt, int nt) {
  const int total = N * (K / 8);
  for (int idx = gt; idx < total; idx += nt) {
    const int n = idx % N, kc = idx / N;
    unsigned o[4];
#pragma unroll
    for (int j = 0; j < 4; ++j) o[j] = pack2(W[(size_t)(kc * 8 + 2 * j) * N + n], W[(size_t)(kc * 8 + 2 * j + 1) * N + n]);
    *(uint4*)(Wt + (size_t)n * K + kc * 8) = make_uint4(o[0], o[1], o[2], o[3]);
  }
}
DI void convert_u_int8(const int tid_, const float* __restrict__ src, uint8_t* __restrict__ dst, float* __restrict__ su, int gw, int nw) {
  const int lane = tid_ & 63;
  for (int e = gw; e < 16384; e += nw) {
    const float4* s4 = (const float4*)(src + (size_t)e * DM);
    float4 v[4];
    float mx = 0.f;
#pragma unroll
    for (int i = 0; i < 4; ++i) { v[i] = s4[lane + 64 * i]; mx = fmaxf(mx, fmaxf(fmaxf(fabsf(v[i].x), fabsf(v[i].y)), fmaxf(fabsf(v[i].z), fabsf(v[i].w)))); }
    mx = wave_max(mx);
    const float inv = mx > 0.f ? 127.0f / mx : 0.f;
    if (lane == 0) su[e] = mx * (1.0f / 127.0f);
#pragma unroll
    for (int i = 0; i < 4; ++i) {
      const unsigned q = ((unsigned)__float2int_rn(v[i].x * inv) & 0xffu) | (((unsigned)__float2int_rn(v[i].y * inv) & 0xffu) << 8) |
                         (((unsigned)__float2int_rn(v[i].z * inv) & 0xffu) << 16) | (((unsigned)__float2int_rn(v[i].w * inv) & 0xffu) << 24);
      const int slice = 2 * i + (lane >> 5);
      *(unsigned*)(dst + ((size_t)slice * 16384 + e) * 128 + 4 * (lane & 31)) = q;
    }
  }
}
DI void convert_subkeys(const float* __restrict__ src, bf16_t* __restrict__ dst, int gt, int nt_) {
  for (int i = gt; i < 8 * 128 * 16; i += nt_) {
    const int grp = i & 15, row = i >> 4;
    const int h = grp & 1, ns = grp >> 1;
    const float* sp = src + (size_t)row * 128 + 16 * ns + 4 * h;
    const float4 a = *(const float4*)sp, b = *(const float4*)(sp + 8);
    *(uint4*)(dst + (size_t)row * 128 + grp * 8) = make_uint4(pack2(a.x, a.y), pack2(a.z, a.w), pack2(b.x, b.y), pack2(b.z, b.w));
  }
}
DI void phase_prep(const int tid_, const Params& p, int bid, int nblk) {
  const int gt = bid * NTHREADS + tid_, nt = nblk * NTHREADS;
  const int gw = gt >> 6, nw = nt >> 6;
  rmsnorm_rows(tid_, p.x, p.g_mix, p.HN, T_TOK, gw, nw);
  rmsnorm_rows(tid_, p.mem, p.g_memtok, p.MEMN, NB * MEMLEN, gw, nw);
  transpose_w(p.w_in, p.WinT, DM, INW, gt, nt);
  transpose_w(p.w_out, p.WoutT, DM, DM, gt, nt);
  transpose_w(p.w_peer_q, p.WqT, DM, 2048, gt, nt);
  transpose_w(p.w_mem_kv, p.WmkvT, DM, 512, gt, nt);
  convert_subkeys(p.sub1, p.SUB1, gt, nt);
  convert_subkeys(p.sub2, p.SUB2, gt, nt);
  convert_u_int8(tid_, p.peer_u, p.U8s, p.SU, gw, nw);
  convert_u_int8(tid_, p.peer_v, p.V8s, p.SV, gw, nw);
}

DI void gemm_stage(const int tid_, const bf16_t* __restrict__ A, const bf16_t* __restrict__ Bt, int K, int m0, int n0, int k0, char* stg) {
  const int lane = tid_ & 63, wave = tid_ >> 6;
  const int lr = lane >> 3, spos = lane & 7;
#pragma unroll
  for (int j = 0; j < 4; ++j) {
    const int row = 32 * wave + 8 * j + lr;
    const int sw = (spos ^ ((row >> 1) & 7)) << 3;
    __builtin_amdgcn_global_load_lds((const unsigned*)(A + (size_t)(m0 + row) * K + k0 + sw),
                                     (LDSP unsigned*)(stg + (32 * wave + 8 * j) * 128 + lane * 16), 16, 0, 0);
  }
#pragma unroll
  for (int j = 0; j < 2; ++j) {
    const int row = 16 * wave + 8 * j + lr;
    const int sw = (spos ^ ((row >> 1) & 7)) << 3;
    __builtin_amdgcn_global_load_lds((const unsigned*)(Bt + (size_t)(n0 + row) * K + k0 + sw),
                                     (LDSP unsigned*)(stg + 32768 + (16 * wave + 8 * j) * 128 + lane * 16), 16, 0, 0);
  }
}
#define RING_WAIT(more_in_flight)                                                     \
  do {                                                                                \
    if (more_in_flight) asm volatile("s_waitcnt vmcnt(6) lgkmcnt(0)" ::: "memory");   \
    else asm volatile("s_waitcnt vmcnt(0) lgkmcnt(0)" ::: "memory");                  \
    __builtin_amdgcn_s_barrier();                                                     \
  } while (0)

#define BIG_STAGE_BYTES 65536
DI void dma16_saddr(const void* sbase, unsigned voff, unsigned lds_dst) {
  unsigned keep;
  asm volatile("s_mov_b32 %0, m0\n\ts_mov_b32 m0, %3\n\ts_nop 0\n\tglobal_load_lds_dwordx4 %1, %2\n\ts_mov_b32 m0, %0"
               : "=&s"(keep) : "v"(voff), "s"(sbase), "s"(lds_dst) : "memory");
}
DI void gemm_big(const int tid_, const bf16_t* __restrict__ A, const bf16_t* __restrict__ Bt, int K, int m0, int n0, char* lds, f32x16 (&acc)[4][2]) {
  const int tid = tid_, lane = tid & 63, wave = tid >> 6;
  const int wm = wave >> 2, wn = wave & 3, r = lane & 31, h = lane >> 5;
#pragma unroll
  for (int a = 0; a < 4; ++a)
#pragma unroll
    for (int b = 0; b < 2; ++b)
#pragma unroll
      for (int i = 0; i < 16; ++i) acc[a][b][i] = 0.f;
  const int nk = K >> 6;
  unsigned loff[4];
#pragma unroll
  for (int j = 0; j < 4; ++j) {
    const int row = 32 * wave + 8 * j + (lane >> 3);
    loff[j] = (unsigned)((row * K + (((lane & 7) ^ ((row >> 1) & 7)) << 3)) * 2);
  }
  const int wave_s = __builtin_amdgcn_readfirstlane(wave);
  const unsigned lds0 = (unsigned)(size_t)lds + (unsigned)(wave_s * 32 * 128);
  const char* Ab = (const char*)(A + (size_t)m0 * K);
  const char* Bb = (const char*)(Bt + (size_t)n0 * K);
  asm volatile("s_waitcnt vmcnt(0)" ::: "memory");
  __syncthreads();
#pragma unroll
  for (int j = 0; j < 4; ++j) { dma16_saddr(Ab, loff[j], lds0 + j * 1024); dma16_saddr(Bb, loff[j], lds0 + 32768 + j * 1024); }
  int aoff[4], boff[2];
  const int fsw = (r >> 1) & 7;
#pragma unroll
  for (int t = 0; t < 4; ++t) aoff[t] = (wm * 128 + t * 32 + r) * 128;
#pragma unroll
  for (int t = 0; t < 2; ++t) boff[t] = 32768 + (wn * 64 + t * 32 + r) * 128;
  for (int kt = 0; kt < nk; ++kt) {
    asm volatile("s_waitcnt vmcnt(0) lgkmcnt(0)" ::: "memory");
    __builtin_amdgcn_s_barrier();
    const char* Sc = lds + (kt & 1) * BIG_STAGE_BYTES;
    const unsigned ldn = lds0 + (unsigned)(((kt + 1) & 1) * BIG_STAGE_BYTES);
    const bool more = kt + 1 < nk;
    const char* An = Ab + (size_t)(kt + 1) * 128;
    const char* Bn = Bb + (size_t)(kt + 1) * 128;
    bf16x8 af[2][4], bfr[2][2];
    {
      const int co = (h ^ fsw) << 4;
#pragma unroll
      for (int t = 0; t < 4; ++t) af[0][t] = *(const bf16x8*)(Sc + aoff[t] + co);
#pragma unroll
      for (int t = 0; t < 2; ++t) bfr[0][t] = *(const bf16x8*)(Sc + boff[t] + co);
    }
#pragma unroll
    for (int s = 0; s < 4; ++s) {
      if (s < 3) {
        const int co = ((2 * (s + 1) + h) ^ fsw) << 4;
#pragma unroll
        for (int t = 0; t < 4; ++t) af[(s + 1) & 1][t] = *(const bf16x8*)(Sc + aoff[t] + co);
#pragma unroll
        for (int t = 0; t < 2; ++t) bfr[(s + 1) & 1][t] = *(const bf16x8*)(Sc + boff[t] + co);
      }
      if (more && s < 2) {
        dma16_saddr(An, loff[2 * s], ldn + (2 * s) * 1024); dma16_saddr(Bn, loff[2 * s], ldn + 32768 + (2 * s) * 1024);
        dma16_saddr(An, loff[2 * s + 1], ldn + (2 * s + 1) * 1024); dma16_saddr(Bn, loff[2 * s + 1], ldn + 32768 + (2 * s + 1) * 1024);
      }
      __builtin_amdgcn_sched_barrier(0);
      __builtin_amdgcn_s_setprio(1);
#pragma unroll
      for (int a = 0; a < 4; ++a)
#pragma unroll
        for (int b = 0; b < 2; ++b) acc[a][b] = __builtin_amdgcn_mfma_f32_32x32x16_bf16(af[s & 1][a], bfr[s & 1][b], acc[a][b], 0, 0, 0);
      __builtin_amdgcn_s_setprio(0);
      __builtin_amdgcn_sched_barrier(0);
    }
  }
}
DI void gemm_big_dump(const int tid_, const f32x16 (&acc)[4][2], int pass, char* lds) {
  const int lane = tid_ & 63, wave = tid_ >> 6;
  const int wm = wave >> 2, wn = wave & 3, r = lane & 31, h = lane >> 5;
  __syncthreads();
  if ((wn >> 1) == pass) {
    float* Cs = (float*)lds;
#pragma unroll
    for (int a = 0; a < 4; ++a)
#pragma unroll
      for (int b = 0; b < 2; ++b)
#pragma unroll
        for (int i = 0; i < 16; ++i) Cs[(wm * 128 + a * 32 + crow(i, h)) * 132 + (wn & 1) * 64 + b * 32 + r] = acc[a][b][i];
  }
  __syncthreads();
}

#define KM_TOTAL (NB * 6 * 16 * 64)
#define X1B(p) ((p).QKV + (size_t)8 * T_TOK * 128)
DI void epi_headnorm(const int tid_, const float* Cs, bf16_t* __restrict__ dst, size_t rows_total, int m0, int g0, const float* gain0, const float* gain1,
                     bf16_t* kmean = nullptr, float* red = nullptr, float qscale = 1.0f) {
  const int tid = tid_;
  float csum[8] = {0.f, 0.f, 0.f, 0.f, 0.f, 0.f, 0.f, 0.f};
#pragma unroll 1
  for (int it = 0; it < 8; ++it) {
    const int task = tid + NTHREADS * it;
    const int sub = task & 7, grp = (task >> 3) & 1, row = task >> 4;
    const float4 c0 = *(const float4*)(Cs + row * 132 + grp * 64 + sub * 8);
    const float4 c1 = *(const float4*)(Cs + row * 132 + grp * 64 + sub * 8 + 4);
    float v[8] = {c0.x, c0.y, c0.z, c0.w, c1.x, c1.y, c1.z, c1.w};
    const float* gain = grp ? gain1 : gain0;
    float ss = 0.f;
#pragma unroll
    for (int j = 0; j < 8; ++j) ss += v[j] * v[j];
    ss = sum8(ss);
    if (gain) {
      const float rinv = rsqrtf(ss * (1.0f / 64.0f) + 1e-6f) * qscale;
#pragma unroll
      for (int j = 0; j < 8; ++j) v[j] *= rinv * gain[sub * 8 + j];
    }
    *(uint4*)(dst + ((size_t)(g0 + grp) * rows_total + m0 + row) * 64 + sub * 8) =
        make_uint4(pack2(v[0], v[1]), pack2(v[2], v[3]), pack2(v[4], v[5]), pack2(v[6], v[7]));
    if (kmean) {
#pragma unroll
      for (int j = 0; j < 8; ++j) csum[j] += v[j];
    }
  }
  if (kmean) {
#pragma unroll
    for (int j = 0; j < 8; ++j) red[(tid >> 4) * 128 + (tid & 15) * 8 + j] = csum[j];
    __syncthreads();
    if (tid < 128) {
      float a = 0.f;
#pragma unroll 8
      for (int rgrp = 0; rgrp < 32; ++rgrp) a += red[rgrp * 128 + tid];
      const float av = a * (1.0f / 256.0f);
      const unsigned ph = pack2(av, 0.f) & 0xffffu;
      const unsigned pl = pack2(av - __uint_as_float(ph << 16), 0.f) & 0xffffu;
      kmean[(tid >> 6) * 1024 + (tid & 63)] = (bf16_t)ph;
      kmean[KM_TOTAL + (tid >> 6) * 1024 + (tid & 63)] = (bf16_t)pl;
    }
  }
}
DI const float* gain_for_group(const Params& p, int g) {
  const int kind = g / 6;
  switch (kind) {
    case 0: return p.qg_dil;
    case 1: return p.kg_dil;
    case 3: return p.qg_moba;
    case 4: return p.kg_moba;
    case 6: return p.qg_mem;
    default: return nullptr;
  }
}

DI bool xcd_tile_big(int bid, int nblk, int it, int n_tiles_n, int& mt, int& nt) {
  const int x = bid & 7, j = bid >> 3, nb = nblk >> 3;
  const int seq = it * nb + j;
  if (seq >= 32 * n_tiles_n) return false;
  const int per_group = 4 * n_tiles_n;
  const int mg = seq / per_group, rem = seq - mg * per_group;
  nt = rem >> 2; mt = x * 32 + mg * 4 + (rem & 3);
  return true;
}

DI void phase_proj(const int tid_, const Params& p, int bid, int nblk, char* lds) {
  int mt, nt;
  f32x16 acc[4][2];
  for (int it = 0; xcd_tile_big(bid, nblk, it, 10, mt, nt); ++it) {
    gemm_big(tid_, p.HN, p.WinT, DM, mt * 256, nt * 256, lds, acc);
#pragma unroll 1
    for (int pass = 0; pass < 2; ++pass) {
      gemm_big_dump(tid_, acc, pass, lds);
      const int g0 = nt * 4 + pass * 2;
      bf16_t* km = (g0 >= 24 && g0 < 30) ? (bf16_t*)p.KMEAN + ((size_t)((mt >> 4) * 6 + (g0 - 24)) * 16 + (mt & 15)) * 64 : nullptr;
      epi_headnorm(tid_, (const float*)lds, p.QKV, T_TOK, mt * 256, g0, gain_for_group(p, g0), gain_for_group(p, g0 + 1), km, (float*)(lds + RING_BYTES),
                   (g0 < 6 || (g0 >= 18 && g0 < 24) || g0 >= 36) ? 0.125f * 1.4426950408889634f : 1.0f);
    }
  }
  for (int t2 = bid; t2 < 16 * 2; t2 += nblk) {
    const int mt2 = t2 >> 1, nt2 = t2 & 1;
    gemm_big(tid_, p.MEMN, p.WmkvT, DM, mt2 * 256, nt2 * 256, lds, acc);
#pragma unroll 1
    for (int pass = 0; pass < 2; ++pass) {
      gemm_big_dump(tid_, acc, pass, lds);
      const float* gn = (nt2 == 0) ? p.kg_mem : nullptr;
      epi_headnorm(tid_, (const float*)lds, p.KVM, NB * MEMLEN, mt2 * 256, nt2 * 4 + pass * 2, gn, gn);
    }
  }
}

DI float alibi_slope(int i) { return exp2f(-8.0f * (float)(i + 1) / 12.0f); }

#define LOG2E 1.4426950408889634f
#define ATT_SCALE2 (0.125f * LOG2E)
#define MASKVAL (-3.0e38f)

struct AttnState { float m, l; f32x16 o[2]; };

template <bool BIAS>
DI void attn_tile64(const int tid_, const char* Kl, const char* Vl, const bf16x8 (&qf)[4], AttnState& st, float A, const float (&Bc)[2][16],
                    float dqh, int mode0, int mode1, bool colvalid, float lo, float hi) {
  const int lane = tid_ & 63, r = lane & 31, h = lane >> 5;
  f32x16 s0, s1;
#pragma unroll
  for (int i = 0; i < 16; ++i) { s0[i] = 0.f; s1[i] = 0.f; }
  const char* kp = Kl + r * 128;
  const int ksw = (r >> 1) & 7;
#pragma unroll
  for (int ks = 0; ks < 4; ++ks) {
    const bf16x8 k0 = *(const bf16x8*)(kp + (((2 * ks + h) ^ ksw) << 4));
    const bf16x8 k1 = *(const bf16x8*)(kp + 4096 + (((2 * ks + h) ^ ksw) << 4));
    s0 = __builtin_amdgcn_mfma_f32_32x32x16_bf16(k0, qf[ks], s0, 0, 0, 0);
    s1 = __builtin_amdgcn_mfma_f32_32x32x16_bf16(k1, qf[ks], s1, 0, 0, 0);
  }
  const f32x2 sc2 = {ATT_SCALE2, ATT_SCALE2};
#pragma unroll
  for (int j = 0; j < 8; ++j) {
    f32x2 a0 = {s0[2 * j], s0[2 * j + 1]}, a1 = {s1[2 * j], s1[2 * j + 1]};
    if (BIAS) {
      const f32x2 b0 = {Bc[0][2 * j], Bc[0][2 * j + 1]}, b1 = {Bc[1][2 * j], Bc[1][2 * j + 1]};
      a0 = __builtin_elementwise_fma(a0, sc2, b0); a1 = __builtin_elementwise_fma(a1, sc2, b1);
    } else { a0 = a0 * sc2; a1 = a1 * sc2; }
    s0[2 * j] = a0[0]; s0[2 * j + 1] = a0[1]; s1[2 * j] = a1[0]; s1[2 * j + 1] = a1[1];
  }
  if (BIAS && mode0 != 1) {
#pragma unroll
    for (int i = 0; i < 16; ++i) {
      const float delta = dqh - (float)((i & 3) + 8 * (i >> 2));
      s0[i] = (mode0 == 2 && delta >= lo && delta <= hi) ? s0[i] : MASKVAL;
    }
  }
  if (BIAS && mode1 != 1) {
#pragma unroll
    for (int i = 0; i < 16; ++i) {
      const float delta = dqh - (float)(32 + (i & 3) + 8 * (i >> 2));
      s1[i] = (mode1 == 2 && delta >= lo && delta <= hi) ? s1[i] : MASKVAL;
    }
  }
  float tmax = __builtin_fmaxf(s0[0], s1[0]);
#pragma unroll
  for (int i = 1; i < 16; ++i) tmax = __builtin_fmaxf(__builtin_fmaxf(tmax, s0[i]), s1[i]);
  tmax += A;
  tmax = colvalid ? tmax : MASKVAL;
  tmax = fmaxf(tmax, __shfl_xor(tmax, 32));
  const float mnew = fmaxf(st.m, tmax);
  const float alpha = __builtin_amdgcn_exp2f(st.m - mnew);
  st.m = mnew;
  const float dsub = colvalid ? mnew - A : 3.0e38f;
  const f32x2 nd2 = {-dsub, -dsub};
  f32x2 ps0 = {0.f, 0.f}, ps1 = {0.f, 0.f};
#pragma unroll
  for (int j = 0; j < 8; ++j) {
    f32x2 a0 = {s0[2 * j], s0[2 * j + 1]}, a1 = {s1[2 * j], s1[2 * j + 1]};
    a0 = a0 + nd2; a1 = a1 + nd2;
    a0[0] = __builtin_amdgcn_exp2f(a0[0]); a0[1] = __builtin_amdgcn_exp2f(a0[1]);
    a1[0] = __builtin_amdgcn_exp2f(a1[0]); a1[1] = __builtin_amdgcn_exp2f(a1[1]);
    ps0 = ps0 + a0; ps1 = ps1 + a1;
    s0[2 * j] = a0[0]; s0[2 * j + 1] = a0[1]; s1[2 * j] = a1[0]; s1[2 * j + 1] = a1[1];
  }
  ps0 = ps0 + ps1;
  st.l = st.l * alpha + (ps0[0] + ps0[1]);
  if (__ballot(alpha != 1.0f) != 0ull) {
#pragma unroll
    for (int i = 0; i < 16; ++i) { st.o[0][i] *= alpha; st.o[1][i] *= alpha; }
  }
  const int q4 = (lane & 15) >> 2, p4 = lane & 3, g = (lane >> 4) & 1;
#pragma unroll
  for (int s2 = 0; s2 < 4; ++s2) {
    u32x4 pk;
    if (s2 < 2) {
      pk[0] = pack2(s0[8 * s2 + 0], s0[8 * s2 + 1]); pk[1] = pack2(s0[8 * s2 + 2], s0[8 * s2 + 3]);
      pk[2] = pack2(s0[8 * s2 + 4], s0[8 * s2 + 5]); pk[3] = pack2(s0[8 * s2 + 6], s0[8 * s2 + 7]);
    } else {
      pk[0] = pack2(s1[8 * (s2 - 2) + 0], s1[8 * (s2 - 2) + 1]); pk[1] = pack2(s1[8 * (s2 - 2) + 2], s1[8 * (s2 - 2) + 3]);
      pk[2] = pack2(s1[8 * (s2 - 2) + 4], s1[8 * (s2 - 2) + 5]); pk[3] = pack2(s1[8 * (s2 - 2) + 6], s1[8 * (s2 - 2) + 7]);
    }
    const bf16x8 pf = __builtin_bit_cast(bf16x8, pk);
    const int row_lo = 16 * s2 + 4 * h + q4;
    const int row_hi = row_lo + 8;
    const int sw_lo = ((row_lo >> 1) & 1) << 6, sw_hi = ((row_hi >> 1) & 1) << 6;
#pragma unroll
    for (int dt = 0; dt < 2; ++dt) {
      const int cb = 64 * dt + 32 * g + 8 * p4;
      const s16x4 lo4 = __builtin_amdgcn_ds_read_tr16_b64_v4i16((LDSP s16x4*)(Vl + row_lo * 128 + (cb ^ sw_lo)));
      const s16x4 hi4 = __builtin_amdgcn_ds_read_tr16_b64_v4i16((LDSP s16x4*)(Vl + row_hi * 128 + (cb ^ sw_hi)));
      const bf16x8 vf = __builtin_shufflevector(lo4, hi4, 0, 1, 2, 3, 4, 5, 6, 7);
      st.o[dt] = __builtin_amdgcn_mfma_f32_32x32x16_bf16(vf, pf, st.o[dt], 0, 0, 0);
    }
  }
}

#define ATT_STAGE_BYTES 16384
#define ATT_NSTAGE 8
#define ATT_LA 6
DI void attn_tile_dma(const int tid_, const bf16_t*& kp, const bf16_t*& vp, long tstride, char* stg) {
  const int lane = tid_ & 63, w8 = tid_ >> 6;
  __builtin_amdgcn_global_load_lds((const unsigned*)kp, (LDSP unsigned*)(stg + w8 * 1024 + lane * 16), 16, 0, 0);
  __builtin_amdgcn_global_load_lds((const unsigned*)vp, (LDSP unsigned*)(stg + 8192 + w8 * 1024 + lane * 16), 16, 0, 0);
  kp += tstride; vp += tstride;
}

template <int TYPE>
DI void attn_item(const int tid_, const Params& p, char* lds, int b, int hd, int m, int c, int res) {
  const int tid = tid_, lane = tid & 63, w8 = tid >> 6, nh = w8 >> 2, w = w8 & 3, r = lane & 31, h = lane >> 5;
  const int n = 2 * m + nh;
  const size_t tb = (size_t)b * SEQ;
  const bf16_t *Q, *Kb, *Vb;
  int d = 1;
  float slope2 = 0.f;
  if (TYPE == 0) {
    Q = p.QKV + ((size_t)(36 + hd) * T_TOK + tb) * 64;
    Kb = p.KVM + ((size_t)hd * (NB * MEMLEN) + (size_t)b * MEMLEN) * 64;
    Vb = p.KVM + ((size_t)(4 + hd) * (NB * MEMLEN) + (size_t)b * MEMLEN) * 64;
  } else if (TYPE == 1) {
    Q = p.QKV + ((size_t)hd * T_TOK + tb) * 64;
    Kb = p.QKV + ((size_t)(6 + hd) * T_TOK + tb) * 64;
    Vb = p.QKV + ((size_t)(12 + hd) * T_TOK + tb) * 64;
    d = (c == 0) ? 1 : (c == 1 ? 4 : 16);
    slope2 = alibi_slope(2 * hd) * (float)d * LOG2E;
  } else {
    Q = p.QKV + ((size_t)(18 + hd) * T_TOK + tb) * 64;
    Kb = p.QKV + ((size_t)(24 + hd) * T_TOK + tb) * 64;
    Vb = p.QKV + ((size_t)(30 + hd) * T_TOK + tb) * 64;
    slope2 = alibi_slope(2 * hd + 1) * LOG2E;
  }
  int t_lo, t_hi;
  long krow0, kstride;
  if (TYPE == 0) { t_lo = 0; t_hi = 4; krow0 = 0; kstride = 1; }
  else if (TYPE == 1) { t_lo = (m == 0) ? 2 : 0; t_hi = 6; krow0 = (long)(128 * (2 * m - 1)) * d + res; kstride = d; }
  else { t_lo = 0; t_hi = 4 * m + 4; krow0 = 0; kstride = 1; }

  const bf16_t* kp;
  const bf16_t* vp;
  {
    const int row = 8 * w8 + (lane >> 3), pos = lane & 7;
    const long grow = krow0 + ((long)t_lo * 64 + row) * kstride;
    kp = Kb + grow * 64 + ((pos ^ ((row >> 1) & 7)) << 3);
    vp = Vb + grow * 64 + ((pos ^ (((row >> 1) & 1) << 2)) << 3);
  }
  const long tstride = 64 * kstride * 64;
  {
    const int npro = (t_hi - t_lo) < ATT_LA ? (t_hi - t_lo) : ATT_LA;
    for (int i = 0; i < npro; ++i) attn_tile_dma(tid_, kp, vp, tstride, lds + i * ATT_STAGE_BYTES);
  }
  const int qsub = 128 * n + 32 * w + r;
  const long qrow = (TYPE == 1) ? ((long)qsub * d + res) : (long)qsub;
  bf16x8 qf[4];
#pragma unroll
  for (int ks = 0; ks < 4; ++ks) qf[ks] = *(const bf16x8*)(Q + qrow * 64 + (2 * ks + h) * 8);

  unsigned selmask = 0;
  const int own = n >> 1;
  if (TYPE == 2 && own > 0) {
    float qv[32];
#pragma unroll
    for (int ks = 0; ks < 4; ++ks)
#pragma unroll
      for (int j = 0; j < 8; ++j) qv[ks * 8 + j] = bf2f((bf16_t)qf[ks][j]);
    const float* km = p.KMEAN + (size_t)(b * 6 + hd) * 16 * 64;
    float v0 = -3.4e38f, v1 = -3.4e38f, v2 = -3.4e38f;
    int i0 = 31, i1 = 31, i2 = 31;
    for (int j = 0; j < own; ++j) {
      float part = 0.f;
#pragma unroll
      for (int ks = 0; ks < 4; ++ks) {
        const float4 k0 = *(const float4*)(km + j * 64 + 16 * ks + 8 * h);
        const float4 k1 = *(const float4*)(km + j * 64 + 16 * ks + 8 * h + 4);
        part += qv[ks * 8 + 0] * k0.x + qv[ks * 8 + 1] * k0.y + qv[ks * 8 + 2] * k0.z + qv[ks * 8 + 3] * k0.w +
                qv[ks * 8 + 4] * k1.x + qv[ks * 8 + 5] * k1.y + qv[ks * 8 + 6] * k1.z + qv[ks * 8 + 7] * k1.w;
      }
      const float gte = part + __shfl_xor(part, 32);
      if (gte > v2) {
        if (gte > v1) {
          v2 = v1; i2 = i1;
          if (gte > v0) { v1 = v0; i1 = i0; v0 = gte; i0 = j; } else { v1 = gte; i1 = j; }
        } else { v2 = gte; i2 = j; }
      }
    }
    selmask = ((1u << i0) | (1u << i1) | (1u << i2)) & 0xffffu;
  }

  AttnState st;
  st.m = -1.0e30f; st.l = 0.f;
#pragma unroll
  for (int i = 0; i < 16; ++i) { st.o[0][i] = 0.f; st.o[1][i] = 0.f; }

  float Bc[2][16];
#pragma unroll
  for (int i = 0; i < 16; ++i) { Bc[0][i] = slope2 * (float)((i & 3) + 8 * (i >> 2)); Bc[1][i] = slope2 * (float)(32 + (i & 3) + 8 * (i >> 2)); }
  for (int t = t_lo; t < t_hi; ++t) {
    int ahead = t_hi - 1 - t;
    ahead = ahead > ATT_LA - 1 ? ATT_LA - 1 : ahead;
    switch (ahead) {
      case 5: asm volatile("s_waitcnt vmcnt(10) lgkmcnt(0)" ::: "memory"); break;
      case 4: asm volatile("s_waitcnt vmcnt(8) lgkmcnt(0)" ::: "memory"); break;
      case 3: asm volatile("s_waitcnt vmcnt(6) lgkmcnt(0)" ::: "memory"); break;
      case 2: asm volatile("s_waitcnt vmcnt(4) lgkmcnt(0)" ::: "memory"); break;
      case 1: asm volatile("s_waitcnt vmcnt(2) lgkmcnt(0)" ::: "memory"); break;
      default: asm volatile("s_waitcnt vmcnt(0) lgkmcnt(0)" ::: "memory"); break;
    }
    __builtin_amdgcn_s_barrier();
    if (t + ATT_LA < t_hi) attn_tile_dma(tid_, kp, vp, tstride, lds + ((t + ATT_LA - t_lo) & (ATT_NSTAGE - 1)) * ATT_STAGE_BYTES);
    const char* buf = lds + ((t - t_lo) & (ATT_NSTAGE - 1)) * ATT_STAGE_BYTES;
    int mode0 = 1, mode1 = 1;
    bool cv = true;
    float dq = 0.f, lo = 0.f, hi = 0.f;
    if (TYPE == 1) {
      const int ur0 = 2 * t - 4 * nh, ur1 = ur0 + 1;
      mode0 = (ur0 < w || ur0 > w + 4) ? 0 : ((ur0 == w || ur0 == w + 4) ? 2 : 1);
      mode1 = (ur1 < w || ur1 > w + 4) ? 0 : ((ur1 == w || ur1 == w + 4) ? 2 : 1);
      lo = 0.f; hi = 128.f;
      dq = (float)(qsub - (128 * (2 * m - 1) + 64 * t));
    } else if (TYPE == 2) {
      dq = (float)(qsub - 64 * t);
      if (t < 4 * m) { cv = (selmask >> (t >> 2)) & 1u; }
      else {
        const int uq = 4 * n + w;
        mode0 = (2 * t > uq) ? 0 : ((2 * t == uq) ? 2 : 1);
        mode1 = (2 * t + 1 > uq) ? 0 : ((2 * t + 1 == uq) ? 2 : 1);
        lo = 0.f; hi = 1.0e30f;
      }
    }
    if (mode0 == 0 && mode1 == 0) continue;
    const float dqh = dq - (float)(4 * h);
    attn_tile64<(TYPE != 0)>(tid_, buf, buf + 8192, qf, st, -slope2 * dqh, Bc, dqh, mode0, mode1, cv, lo, hi);
  }
  __syncthreads();

  const float ltot = st.l + __shfl_xor(st.l, 32);
  const float inv = 1.0f / ltot;
  bf16_t* dst;
  if (TYPE == 0) dst = p.HN + (tb + qsub) * DM + 768 + hd * 64;
  else if (TYPE == 2) dst = p.HN + (tb + qsub) * DM + 384 + hd * 64;
  else {
    const size_t tok = tb + (size_t)qrow;
    dst = p.DILO + ((size_t)c * T_TOK + tok) * 384 + hd * 64;
    if (h == 0) p.LSE2[((size_t)c * T_TOK + tok) * 6 + hd] = st.m + __builtin_amdgcn_logf(ltot);
  }
#pragma unroll
  for (int dt = 0; dt < 2; ++dt)
#pragma unroll
    for (int gq = 0; gq < 4; ++gq) {
      uint2 o;
      o.x = pack2(st.o[dt][4 * gq + 0] * inv, st.o[dt][4 * gq + 1] * inv);
      o.y = pack2(st.o[dt][4 * gq + 2] * inv, st.o[dt][4 * gq + 3] * inv);
      *(uint2*)(dst + 32 * dt + 8 * gq + 4 * h) = o;
    }
}

#define AH_SLOTB 8192
#define AH_LDS_K 0
#define AH_LDS_V (3 * AH_SLOTB)
#define AH_THR 8.0f
#define AH_SBAR() __builtin_amdgcn_sched_barrier(0)
#define AH_PIN(x) asm volatile("" : "+v"(x))
#define AH_MFMA(a, b, c) __builtin_amdgcn_mfma_f32_32x32x16_bf16(a, b, c, 0, 0, 0)
#define AH_WAIT_BAR(N) asm volatile("s_waitcnt vmcnt(" #N ") lgkmcnt(0)\n\ts_barrier" ::: "memory")
typedef __attribute__((address_space(3))) const char* ah_lds_cptr;
DI void ah_kload2(bf16x8* kf, ah_lds_cptr kp, int d0) {
  kf[2 * d0] = *(const __attribute__((address_space(3))) bf16x8*)(kp + d0 * 2048);
  kf[2 * d0 + 1] = *(const __attribute__((address_space(3))) bf16x8*)(kp + d0 * 2048 + 512);
}
DI s16x4 ah_vtr(ah_lds_cptr p) { return __builtin_amdgcn_ds_read_tr16_b64_v4i16((__attribute__((address_space(3))) s16x4*)p); }
#define AH_MX3(a, b, c) __builtin_fmaxf(__builtin_fmaxf((a), (b)), (c))
DI float ah_rowmax(const f32x16& p0, const f32x16& p1) {
  float a = AH_MX3(p0[0], p0[1], p1[0]), b = AH_MX3(p0[2], p0[3], p1[1]); a = AH_MX3(a, p1[2], p1[3]);
#pragma unroll
  for (int r = 4; r < 16; r += 4) { a = AH_MX3(a, p0[r], p0[r + 1]); b = AH_MX3(b, p0[r + 2], p0[r + 3]); a = AH_MX3(a, p1[r], p1[r + 1]); b = AH_MX3(b, p1[r + 2], p1[r + 3]); }
  const float m = __builtin_fmaxf(a, b);
  auto rr = __builtin_amdgcn_permlane32_swap(__float_as_uint(m), __float_as_uint(m), false, false);
  return __builtin_fmaxf(__uint_as_float(rr[0]), __uint_as_float(rr[1]));
}
DI void ah_cmask(f32x16& p0, f32x16& p1, int jb, int qrel, int hi) {
  const int kb = 64 * jb + 4 * hi;
#pragma unroll
  for (int r = 0; r < 16; ++r) { const int kv = kb + (r & 3) + 8 * (r >> 2); if (kv > qrel) p0[r] = -INFINITY; if (kv + 32 > qrel) p1[r] = -INFINITY; }
}

template <int TYPE>
DI void attn_unit_hi(const int tid_, const Params& p, char* lds, int b, int hd, int m) {
  const int tid = tid_, lane = tid & 63, r32 = lane & 31, hi = lane >> 5;
  const int wid = __builtin_amdgcn_readfirstlane(tid >> 6);
  const size_t tb = (size_t)b * SEQ;
  const bf16_t *Q, *Kb, *Vb;
  float slope2 = 0.f;
  if (TYPE == 0) {
    Q = p.QKV + ((size_t)(36 + hd) * T_TOK + tb) * 64;
    Kb = p.KVM + ((size_t)hd * (NB * MEMLEN) + (size_t)b * MEMLEN) * 64;
    Vb = p.KVM + ((size_t)(4 + hd) * (NB * MEMLEN) + (size_t)b * MEMLEN) * 64;
  } else {
    Q = p.QKV + ((size_t)(18 + hd) * T_TOK + tb) * 64;
    Kb = p.QKV + ((size_t)(24 + hd) * T_TOK + tb) * 64;
    Vb = p.QKV + ((size_t)(30 + hd) * T_TOK + tb) * 64;
    slope2 = alibi_slope(2 * hd + 1) * LOG2E;
  }
  const int q0 = 256 * m, NT = (TYPE == 0) ? 4 : 4 * m + 4;
  const bf16_t* Qw = Q + (size_t)(q0 + wid * 32) * 64;
  const unsigned lds0 = (unsigned)(size_t)lds;
  const unsigned koff = (unsigned)((lane * 64 + wid * 8) * 2);
  const unsigned voff = (unsigned)(((16 * (wid & 3) + (lane >> 2)) * 64 + (wid >> 2) * 32 + (lane & 3) * 8) * 2);
  const unsigned kdst = lds0 + AH_LDS_K + wid * 1024, vdst = lds0 + AH_LDS_V + wid * 1024;
  const char* Kc = (const char*)Kb;
  const char* Vc = (const char*)Vb;
#define AH_TA(u) ((TYPE == 2) ? (NT - 1 - (u)) : (u))
#define AH_DMA_K(t, slot) dma16_saddr(Kc + (size_t)AH_TA(t) * 8192, koff, kdst + (unsigned)(slot))
#define AH_DMA_V(t, slot) dma16_saddr(Vc + (size_t)AH_TA(t) * 8192, voff, vdst + (unsigned)(slot))
  const ah_lds_cptr vp0 = (ah_lds_cptr)lds + AH_LDS_V + ((lane >> 4) & 1) * 32 + (lane & 3) * 8 + (4 * hi + ((lane & 15) >> 2)) * 64;
  const ah_lds_cptr kp0 = (ah_lds_cptr)lds + AH_LDS_K + hi * 1024 + r32 * 16;
  AH_DMA_K(0, 0); AH_DMA_V(0, 0); AH_DMA_K(1, AH_SLOTB);
  bf16x8 qr[4];
#pragma unroll
  for (int d0 = 0; d0 < 4; ++d0) qr[d0] = *(const bf16x8*)(Qw + (size_t)r32 * 64 + d0 * 16 + hi * 8);
  unsigned selmask = 0;
  if (TYPE == 2 && m > 0) {
    const bf16_t* kmh = (const bf16_t*)p.KMEAN + (size_t)(b * 6 + hd) * 16 * 64 + (r32 & 15) * 64 + 8 * hi;
    bf16x8 ah[4], al[4];
#pragma unroll
    for (int ks = 0; ks < 4; ++ks) { ah[ks] = *(const bf16x8*)(kmh + 16 * ks); al[ks] = *(const bf16x8*)(kmh + KM_TOTAL + 16 * ks); }
    f32x16 g;
#pragma unroll
    for (int i = 0; i < 16; ++i) g[i] = 0.f;
#pragma unroll
    for (int ks = 0; ks < 4; ++ks) { g = AH_MFMA(ah[ks], qr[ks], g); g = AH_MFMA(al[ks], qr[ks], g); }
    float gv[16];
#pragma unroll
    for (int i = 0; i < 8; ++i) {
      auto rr = __builtin_amdgcn_permlane32_swap(__float_as_uint(g[i]), __float_as_uint(g[i]), false, false);
      gv[(i & 3) + 8 * (i >> 2)] = __uint_as_float(rr[0]);
      gv[(i & 3) + 8 * (i >> 2) + 4] = __uint_as_float(rr[1]);
    }
    float v0 = -3.4e38f, v1 = -3.4e38f, v2 = -3.4e38f;
    int i0 = 31, i1 = 31, i2 = 31;
#pragma unroll
    for (int j = 0; j < 16; ++j) {
      const float gte = gv[j];
      if (j < m && gte > v2) {
        if (gte > v1) {
          v2 = v1; i2 = i1;
          if (gte > v0) { v1 = v0; i1 = i0; v0 = gte; i0 = j; } else { v1 = gte; i1 = j; }
        } else { v2 = gte; i2 = j; }
      }
    }
    selmask = ((1u << i0) | (1u << i1) | (1u << i2)) & 0xffffu;
  }
  float mhat = 0.f, l_reg = 0.f, fres = 1.f;
  f32x16 o[2];
#pragma unroll
  for (int i = 0; i < 16; ++i) { o[0][i] = 0.f; o[1][i] = 0.f; }
  f32x16 zero16;
#pragma unroll
  for (int i = 0; i < 16; ++i) zero16[i] = 0.f;
  if (TYPE == 0) AH_PIN(zero16);
  const int qrel = wid * 32 + r32;
  const float qposh = (float)(q0 + qrel - 4 * hi);
  bool resc = false;
  f32x16 pA0, pA1, pB0, pB1;
  bf16x8 kf[8];
  s16x4 vlo[8], vhi[8];
  u32x4 pw0, pw1, pw2, pw3;
  int sl_prev = 0, sl_cur = 0, sl_next = AH_SLOTB;
#define AH_ROT() do { sl_prev = sl_cur; sl_cur = sl_next; sl_next = (sl_next == 2 * AH_SLOTB) ? 0 : sl_next + AH_SLOTB; } while (0)
#define AH_INIT(C0, C1, u, ref)                                                                                     \
  do {                                                                                                              \
    if (TYPE == 2) {                                                                                                \
      const int ta_ = AH_TA(u);                                                                                     \
      const bool cv_ = (ta_ >= 4 * m) || ((selmask >> (ta_ >> 2)) & 1u);                                            \
      const float s_ = cv_ ? (-slope2 * (qposh - (float)(64 * ta_)) - (ref)) : -1.0e30f;                            \
      _Pragma("unroll") for (int i_ = 0; i_ < 16; ++i_) {                                                           \
        C0[i_] = __builtin_fmaf(slope2, (float)((i_ & 3) + 8 * (i_ >> 2)), s_);                                     \
        C1[i_] = __builtin_fmaf(slope2, (float)(32 + (i_ & 3) + 8 * (i_ >> 2)), s_);                                \
      }                                                                                                             \
    }                                                                                                               \
  } while (0)
#define AH_CIN(C) ((TYPE == 2) ? (C) : zero16)
#define AH_EX(v) ((TYPE == 2) ? __builtin_amdgcn_exp2f(v) : __builtin_amdgcn_exp2f((v) + nmh))
#define AH_RESC() do { if (resc) { _Pragma("unroll") for (int r_ = 0; r_ < 16; ++r_) { o[0][r_] *= fres; o[1][r_] *= fres; } } } while (0)
  AH_DMA_K(2, 2 * AH_SLOTB);
  AH_WAIT_BAR(3);
#pragma unroll
  for (int d0 = 0; d0 < 4; ++d0) ah_kload2(kf, kp0, d0);
  AH_INIT(pA0, pA1, 0, 0.f);
  pA0 = AH_MFMA(kf[0], qr[0], AH_CIN(pA0)); pA1 = AH_MFMA(kf[1], qr[0], AH_CIN(pA1)); pA0 = AH_MFMA(kf[2], qr[1], pA0); pA1 = AH_MFMA(kf[3], qr[1], pA1);
  pA0 = AH_MFMA(kf[4], qr[2], pA0); pA1 = AH_MFMA(kf[5], qr[2], pA1); pA0 = AH_MFMA(kf[6], qr[3], pA0); pA1 = AH_MFMA(kf[7], qr[3], pA1);
  if (TYPE == 2) ah_cmask(pA0, pA1, 3, qrel, hi);
  {
    const float rm = ah_rowmax(pA0, pA1);
    mhat = (TYPE == 2) ? __builtin_fmaxf(rm, -1000.0f) : rm;
    const float nm0 = -mhat;
#pragma unroll
    for (int r = 0; r < 16; ++r) { pA0[r] = __builtin_amdgcn_exp2f(pA0[r] + nm0); pA1[r] = __builtin_amdgcn_exp2f(pA1[r] + nm0); }
  }
  AH_WAIT_BAR(0);
  AH_DMA_K(3, 0); AH_DMA_V(1, AH_SLOTB); AH_ROT();
#pragma unroll
  for (int d0 = 0; d0 < 4; ++d0) ah_kload2(kf, kp0 + sl_cur, d0);
  AH_WAIT_BAR(2);
#define AH_PKW(P, i) pack2(P[i], P[i + 1])
#define AH_PAF(k) __builtin_bit_cast(bf16x8, pw##k)
#define AH_VFR(i) (bf16x8){vlo[i][0], vlo[i][1], vlo[i][2], vlo[i][3], vhi[i][0], vhi[i][1], vhi[i][2], vhi[i][3]}
#define AH_VRD(i) do { vlo[i] = ah_vtr(vp_ + (((i) >> 2) * 4096 + ((i) & 3) * 1024)); vhi[i] = ah_vtr(vp_ + (((i) >> 2) * 4096 + ((i) & 3) * 1024 + 512)); } while (0)
#define AH_KRD(G, d0) do { if (G) { ah_kload2(kf, kp0 + sl_next, d0); AH_SBAR(); } } while (0)
#define AH_GAPA(MF, a0, a1, a2, a3, W0, W1, PW) do { MF; sacc += a0; sacc += a1; sacc += a2; sacc += a3; W0; W1; AH_PIN(PW); AH_PIN(sacc); AH_SBAR(); } while (0)
#define AH_GAPB(MF, X, i) do { MF; X[i] = AH_EX(X[i]); X[i + 1] = AH_EX(X[i + 1]); X[i + 2] = AH_EX(X[i + 2]); X[i + 3] = AH_EX(X[i + 3]); AH_PIN(X); AH_SBAR(); } while (0)
#define AH_STEP(C0, C1, P0, P1, t, MASK, GK, GV, GL) do { AH_SBAR(); \
    AH_INIT(C0, C1, (t), mhat); \
    const ah_lds_cptr vp_ = vp0 + sl_prev; \
    AH_VRD(0); AH_SBAR(); float sacc = P0[0] + P0[1]; \
                       AH_GAPA(C0 = AH_MFMA(kf[0], qr[0], AH_CIN(C0)), P0[2], P0[3], P0[4], P0[5],     pw0[0] = AH_PKW(P0, 0),  pw0[1] = AH_PKW(P0, 2),  pw0); \
    AH_VRD(4); AH_SBAR(); AH_GAPA(C1 = AH_MFMA(kf[1], qr[0], AH_CIN(C1)), P0[6], P0[7], P0[8], P0[9],     pw0[2] = AH_PKW(P0, 4),  pw0[3] = AH_PKW(P0, 6),  pw0); \
    AH_VRD(1); AH_SBAR(); AH_GAPA(C0 = AH_MFMA(kf[2], qr[1], C0),    P0[10], P0[11], P0[12], P0[13], pw1[0] = AH_PKW(P0, 8),  pw1[1] = AH_PKW(P0, 10), pw1); \
    AH_VRD(5); AH_SBAR(); AH_GAPA(C1 = AH_MFMA(kf[3], qr[1], C1),    P0[14], P0[15], P1[0], P1[1],   pw1[2] = AH_PKW(P0, 12), pw1[3] = AH_PKW(P0, 14), pw1); \
    AH_VRD(2); AH_SBAR(); AH_GAPA(C0 = AH_MFMA(kf[4], qr[2], C0),    P1[2], P1[3], P1[4], P1[5],     pw2[0] = AH_PKW(P1, 0),  pw2[1] = AH_PKW(P1, 2),  pw2); \
    AH_VRD(6); AH_SBAR(); AH_GAPA(C1 = AH_MFMA(kf[5], qr[2], C1),    P1[6], P1[7], P1[8], P1[9],     pw2[2] = AH_PKW(P1, 4),  pw2[3] = AH_PKW(P1, 6),  pw2); \
    AH_VRD(3); AH_SBAR(); AH_GAPA(C0 = AH_MFMA(kf[6], qr[3], C0),    P1[10], P1[11], P1[12], P1[13], pw3[0] = AH_PKW(P1, 8),  pw3[1] = AH_PKW(P1, 10), pw3); \
    AH_VRD(7); AH_SBAR(); AH_GAPA(C1 = AH_MFMA(kf[7], qr[3], C1),    P1[14], P1[15], 0.f, 0.f,       pw3[2] = AH_PKW(P1, 12), pw3[3] = AH_PKW(P1, 14), pw3); \
    l_reg += sacc; \
    if (GK) AH_DMA_K((t) + 3, sl_cur); if (GV) AH_DMA_V((t) + 1, sl_next); \
    if (MASK) ah_cmask(C0, C1, 3 - (t), qrel, hi); \
    { const float rm = (TYPE == 2) ? ah_rowmax(C0, C1) : ah_rowmax(C0, C1) - mhat; resc = false;        \
      if (__builtin_expect(__any(rm > AH_THR), 0)) { const float dl = __builtin_fmaxf(rm, 0.f); mhat += dl;        \
          fres = __builtin_amdgcn_exp2f(-dl); l_reg *= fres; resc = true; \
          if (TYPE == 2) { _Pragma("unroll") for (int r_ = 0; r_ < 16; ++r_) { C0[r_] -= dl; C1[r_] -= dl; } } } } \
    const float nmh = -mhat; (void)nmh; AH_SBAR(); \
    AH_GAPB(o[0] = AH_MFMA(AH_VFR(0), AH_PAF(0), o[0]), C0, 0);              AH_GAPB(o[1] = AH_MFMA(AH_VFR(4), AH_PAF(0), o[1]), C0, 4); \
    AH_KRD(GL, 0); AH_GAPB(o[0] = AH_MFMA(AH_VFR(1), AH_PAF(1), o[0]), C0, 8);  AH_KRD(GL, 1); AH_GAPB(o[1] = AH_MFMA(AH_VFR(5), AH_PAF(1), o[1]), C0, 12); \
    AH_KRD(GL, 2); AH_GAPB(o[0] = AH_MFMA(AH_VFR(2), AH_PAF(2), o[0]), C1, 0);  AH_KRD(GL, 3); AH_GAPB(o[1] = AH_MFMA(AH_VFR(6), AH_PAF(2), o[1]), C1, 4); \
    AH_GAPB(o[0] = AH_MFMA(AH_VFR(3), AH_PAF(3), o[0]), C1, 8);              AH_GAPB(o[1] = AH_MFMA(AH_VFR(7), AH_PAF(3), o[1]), C1, 12); \
  } while (0)
#define AH_ENDW(tt) do { if ((tt) + 3 < NT) { AH_WAIT_BAR(2); } else if ((tt) + 2 < NT) { AH_WAIT_BAR(1); } else { AH_WAIT_BAR(0); } } while (0)
#define AH_PEELED_PAIR() do { \
    AH_STEP(pB0, pB1, pA0, pA1, t, (TYPE == 2 && t < 4), (t + 3 < NT), (t + 1 < NT), (t + 1 < NT));             AH_ENDW(t);     AH_RESC(); AH_ROT(); \
    AH_STEP(pA0, pA1, pB0, pB1, t + 1, (TYPE == 2 && t + 1 < 4), (t + 4 < NT), (t + 2 < NT), (t + 2 < NT));     AH_ENDW(t + 1); AH_RESC(); AH_ROT(); } while (0)
  int t = 1;
  if (TYPE == 2) { for (; t < 5 && t + 1 < NT; t += 2) AH_PEELED_PAIR(); }
  for (; t + 5 < NT; t += 2) {
    AH_STEP(pB0, pB1, pA0, pA1, t, false, true, true, true);     AH_WAIT_BAR(2); AH_RESC(); AH_ROT();
    AH_STEP(pA0, pA1, pB0, pB1, t + 1, false, true, true, true); AH_WAIT_BAR(2); AH_RESC(); AH_ROT();
  }
  for (; t + 1 < NT; t += 2) AH_PEELED_PAIR();
  AH_STEP(pB0, pB1, pA0, pA1, NT - 1, (TYPE == 2 && NT == 4), false, false, false); AH_RESC();
  {
    float sacc = pB0[0] + pB0[1];
#pragma unroll
    for (int r = 2; r < 16; ++r) sacc += pB0[r];
#pragma unroll
    for (int r = 0; r < 16; ++r) sacc += pB1[r];
    l_reg += sacc;
    pw0 = (u32x4){AH_PKW(pB0, 0), AH_PKW(pB0, 2), AH_PKW(pB0, 4), AH_PKW(pB0, 6)}; pw1 = (u32x4){AH_PKW(pB0, 8), AH_PKW(pB0, 10), AH_PKW(pB0, 12), AH_PKW(pB0, 14)};
    pw2 = (u32x4){AH_PKW(pB1, 0), AH_PKW(pB1, 2), AH_PKW(pB1, 4), AH_PKW(pB1, 6)}; pw3 = (u32x4){AH_PKW(pB1, 8), AH_PKW(pB1, 10), AH_PKW(pB1, 12), AH_PKW(pB1, 14)};
    const ah_lds_cptr vp_ = vp0 + sl_cur;
#pragma unroll
    for (int i = 0; i < 8; ++i) AH_VRD(i);
    o[0] = AH_MFMA(AH_VFR(0), AH_PAF(0), o[0]); o[1] = AH_MFMA(AH_VFR(4), AH_PAF(0), o[1]); o[0] = AH_MFMA(AH_VFR(1), AH_PAF(1), o[0]); o[1] = AH_MFMA(AH_VFR(5), AH_PAF(1), o[1]);
    o[0] = AH_MFMA(AH_VFR(2), AH_PAF(2), o[0]); o[1] = AH_MFMA(AH_VFR(6), AH_PAF(2), o[1]); o[0] = AH_MFMA(AH_VFR(3), AH_PAF(3), o[0]); o[1] = AH_MFMA(AH_VFR(7), AH_PAF(3), o[1]);
  }
  const float ltot = l_reg + __shfl_xor(l_reg, 32);
  const float inv = 1.0f / ltot;
  bf16_t* dst = p.HN + (tb + q0 + qrel) * DM + ((TYPE == 0) ? 768 : 384) + hd * 64;
#pragma unroll
  for (int dt = 0; dt < 2; ++dt)
#pragma unroll
    for (int gq = 0; gq < 4; ++gq) {
      uint2 ov;
      ov.x = pack2(o[dt][4 * gq + 0] * inv, o[dt][4 * gq + 1] * inv);
      ov.y = pack2(o[dt][4 * gq + 2] * inv, o[dt][4 * gq + 3] * inv);
      *(uint2*)(dst + 32 * dt + 8 * gq + 4 * hi) = ov;
    }
  asm volatile("s_waitcnt vmcnt(0) lgkmcnt(0)\n\ts_barrier" ::: "memory");
#undef AH_DMA_K
#undef AH_TA
#undef AH_DMA_V
#undef AH_ROT
#undef AH_INIT
#undef AH_CIN
#undef AH_EX
#undef AH_RESC
#undef AH_PKW
#undef AH_PAF
#undef AH_VFR
#undef AH_VRD
#undef AH_KRD
#undef AH_GAPA
#undef AH_GAPB
#undef AH_STEP
#undef AH_ENDW
#undef AH_PEELED_PAIR
}

#define AD_KB 0
#define AD_VB 49152
DI void ad_kload2(bf16x8* kf, ah_lds_cptr kp, int d0) {
  kf[2 * d0] = *(const __attribute__((address_space(3))) bf16x8*)(kp + d0 * 12288);
  kf[2 * d0 + 1] = *(const __attribute__((address_space(3))) bf16x8*)(kp + d0 * 12288 + 512);
}
DI void ad_lmask(f32x16& c, int klo_h, int off) {
#pragma unroll
  for (int r = 0; r < 16; ++r) if (off + (r & 3) + 8 * (r >> 2) < klo_h) c[r] = -INFINITY;
}
DI void ad_umask(f32x16& c, int khi_h, int off) {
#pragma unroll
  for (int r = 0; r < 16; ++r) if (off + (r & 3) + 8 * (r >> 2) > khi_h) c[r] = -INFINITY;
}
DI float ad_rowmax16(const f32x16& p0) {
  float a = AH_MX3(p0[0], p0[1], p0[2]), b = AH_MX3(p0[3], p0[4], p0[5]);
  a = AH_MX3(a, p0[6], p0[7]); b = AH_MX3(b, p0[8], p0[9]); a = AH_MX3(a, p0[10], p0[11]); b = AH_MX3(b, p0[12], p0[13]); a = AH_MX3(a, p0[14], p0[15]);
  const float m = __builtin_fmaxf(a, b);
  auto rr = __builtin_amdgcn_permlane32_swap(__float_as_uint(m), __float_as_uint(m), false, false);
  return __builtin_fmaxf(__uint_as_float(rr[0]), __uint_as_float(rr[1]));
}

DI void attn_unit_dil(const int tid_, const Params& p, char* lds, int b, int hd, int m, int c, int res) {
  const int tid = tid_, lane = tid & 63, r32 = lane & 31, hi = lane >> 5;
  const int wid = __builtin_amdgcn_readfirstlane(tid >> 6);
  const size_t tb = (size_t)b * SEQ;
  const int d = (c == 0) ? 1 : (c == 1 ? 4 : 16);
  const bf16_t* Q = p.QKV + ((size_t)hd * T_TOK + tb) * 64;
  const char* Kc = (const char*)(p.QKV + ((size_t)(6 + hd) * T_TOK + tb) * 64);
  const char* Vc = (const char*)(p.QKV + ((size_t)(12 + hd) * T_TOK + tb) * 64);
  const float slope2 = alibi_slope(2 * hd) * (float)d * LOG2E;
  const unsigned lds0 = (unsigned)(size_t)lds;
  {
    const unsigned koff = (unsigned)(lane * d * 128 + wid * 16);
    const unsigned voff = (unsigned)((16 * (wid & 3) + (lane >> 2)) * d * 128 + (wid >> 2) * 64 + (lane & 3) * 16);
    const unsigned kdst = lds0 + AD_KB + wid * 6144, vdst = lds0 + AD_VB + (wid >> 2) * 24576 + (wid & 3) * 1024;
#pragma unroll
    for (int i = 0; i < 6; ++i) {
      const int ie = (m == 0 && i < 2) ? 2 : i;
      const size_t rowb = ((size_t)((256 * m - 128 + 64 * ie) * d + res)) * 128;
      dma16_saddr(Kc + rowb, koff, kdst + i * 1024);
      dma16_saddr(Vc + rowb, voff, vdst + i * 4096);
    }
  }
  const int qsub = 256 * m + wid * 32 + r32;
  const size_t tok = tb + (size_t)qsub * d + res;
  bf16x8 qr[4];
#pragma unroll
  for (int d0 = 0; d0 < 4; ++d0) qr[d0] = *(const bf16x8*)(Q + ((size_t)qsub * d + res) * 64 + d0 * 16 + hi * 8);
  const int lb = (m == 0 && wid < 4) ? 128 - 32 * wid : 0;
  const ah_lds_cptr kp0 = (ah_lds_cptr)lds + AD_KB + hi * 6144 + (wid * 32 + r32) * 16;
  const ah_lds_cptr vp0 = (ah_lds_cptr)lds + AD_VB + ((lane >> 4) & 1) * 32 + (lane & 3) * 8 + (wid * 32 + 4 * hi + ((lane & 15) >> 2)) * 64;
  float mhat = 0.f, l_reg = 0.f, fres = 1.f;
  f32x16 o[2];
#pragma unroll
  for (int i = 0; i < 16; ++i) { o[0][i] = 0.f; o[1][i] = 0.f; }
  const float qposh = (float)(128 + r32 - 4 * hi);
  bool resc = false;
  f32x16 pA0, pA1, pB0, pB1;
  bf16x8 kf[8];
  s16x4 vlo[8], vhi[8];
  u32x4 pw0, pw1, pw2, pw3;
#define AD_INIT(C, u, koffs, ref) do { const float s_ = -slope2 * (qposh - (float)(64 * (u) + (koffs))) - (ref); \
    _Pragma("unroll") for (int i_ = 0; i_ < 16; ++i_) C[i_] = __builtin_fmaf(slope2, (float)((i_ & 3) + 8 * (i_ >> 2)), s_); } while (0)
#define AD_RESC() do { if (resc) { _Pragma("unroll") for (int r_ = 0; r_ < 16; ++r_) { o[0][r_] *= fres; o[1][r_] *= fres; } } } while (0)
#define AD_PKW(P, i) pack2(P[i], P[i + 1])
#define AD_PAF(k) __builtin_bit_cast(bf16x8, pw##k)
#define AD_VFR(i) (bf16x8){vlo[i][0], vlo[i][1], vlo[i][2], vlo[i][3], vhi[i][0], vhi[i][1], vhi[i][2], vhi[i][3]}
#define AD_VRD(i) do { vlo[i] = ah_vtr(vp_ + (((i) >> 2) * 24576 + ((i) & 3) * 1024)); vhi[i] = ah_vtr(vp_ + (((i) >> 2) * 24576 + ((i) & 3) * 1024 + 512)); } while (0)
#define AD_KRD(G, u, d0) do { if (G) { ad_kload2(kf, kp0 + ((u) + 1) * 1024, d0); AH_SBAR(); } } while (0)
#define AD_GAPA(MF, a0, a1, a2, a3, W0, W1, PW) do { MF; sacc += a0; sacc += a1; sacc += a2; sacc += a3; W0; W1; AH_PIN(PW); AH_PIN(sacc); AH_SBAR(); } while (0)
#define AD_GAPB(MF, EXPS, X, i) do { MF; if (EXPS) { X[i] = __builtin_amdgcn_exp2f(X[i]); X[i + 1] = __builtin_amdgcn_exp2f(X[i + 1]); X[i + 2] = __builtin_amdgcn_exp2f(X[i + 2]); X[i + 3] = __builtin_amdgcn_exp2f(X[i + 3]); AH_PIN(X); } AH_SBAR(); } while (0)
#define AD_MF(G, x) do { if (G) { x; } } while (0)
#define AD_STEP(C0, C1, P0, P1, u, HALF) do { AH_SBAR(); \
    AD_INIT(C0, (u), 0, mhat); if (!(HALF)) AD_INIT(C1, (u), 32, mhat); \
    const ah_lds_cptr vp_ = vp0 + ((u) - 1) * 4096; \
    AD_VRD(0); AH_SBAR(); float sacc = P0[0] + P0[1]; \
                          AD_GAPA(C0 = AH_MFMA(kf[0], qr[0], C0), P0[2], P0[3], P0[4], P0[5],     pw0[0] = AD_PKW(P0, 0),  pw0[1] = AD_PKW(P0, 2),  pw0); \
    AD_VRD(4); AH_SBAR(); AD_GAPA(AD_MF(!(HALF), C1 = AH_MFMA(kf[1], qr[0], C1)), P0[6], P0[7], P0[8], P0[9],     pw0[2] = AD_PKW(P0, 4),  pw0[3] = AD_PKW(P0, 6),  pw0); \
    AD_VRD(1); AH_SBAR(); AD_GAPA(C0 = AH_MFMA(kf[2], qr[1], C0),    P0[10], P0[11], P0[12], P0[13], pw1[0] = AD_PKW(P0, 8),  pw1[1] = AD_PKW(P0, 10), pw1); \
    AD_VRD(5); AH_SBAR(); AD_GAPA(AD_MF(!(HALF), C1 = AH_MFMA(kf[3], qr[1], C1)),    P0[14], P0[15], P1[0], P1[1],   pw1[2] = AD_PKW(P0, 12), pw1[3] = AD_PKW(P0, 14), pw1); \
    AD_VRD(2); AH_SBAR(); AD_GAPA(C0 = AH_MFMA(kf[4], qr[2], C0),    P1[2], P1[3], P1[4], P1[5],     pw2[0] = AD_PKW(P1, 0),  pw2[1] = AD_PKW(P1, 2),  pw2); \
    AD_VRD(6); AH_SBAR(); AD_GAPA(AD_MF(!(HALF), C1 = AH_MFMA(kf[5], qr[2], C1)),    P1[6], P1[7], P1[8], P1[9],     pw2[2] = AD_PKW(P1, 4),  pw2[3] = AD_PKW(P1, 6),  pw2); \
    AD_VRD(3); AH_SBAR(); AD_GAPA(C0 = AH_MFMA(kf[6], qr[3], C0),    P1[10], P1[11], P1[12], P1[13], pw3[0] = AD_PKW(P1, 8),  pw3[1] = AD_PKW(P1, 10), pw3); \
    AD_VRD(7); AH_SBAR(); AD_GAPA(AD_MF(!(HALF), C1 = AH_MFMA(kf[7], qr[3], C1)),    P1[14], P1[15], 0.f, 0.f,       pw3[2] = AD_PKW(P1, 12), pw3[3] = AD_PKW(P1, 14), pw3); \
    l_reg += sacc; \
    if (HALF) ad_umask(C0, r32 - 4 * hi, 0); \
    else if (lb > 64) { ad_lmask(C0, lb - 64 - 4 * hi, 0); ad_lmask(C1, lb - 64 - 4 * hi, 32); } \
    { const float rm = (HALF) ? ad_rowmax16(C0) : ah_rowmax(C0, C1); resc = false; \
      if (__builtin_expect(__any(rm > AH_THR), 0)) { const float dl = __builtin_fmaxf(rm, 0.f); mhat += dl; \
          fres = __builtin_amdgcn_exp2f(-dl); l_reg *= fres; resc = true; \
          _Pragma("unroll") for (int r_ = 0; r_ < 16; ++r_) { C0[r_] -= dl; if (!(HALF)) C1[r_] -= dl; } } } \
    AH_SBAR(); \
    AD_GAPB(o[0] = AH_MFMA(AD_VFR(0), AD_PAF(0), o[0]), true, C0, 0);                      AD_GAPB(o[1] = AH_MFMA(AD_VFR(4), AD_PAF(0), o[1]), true, C0, 4); \
    AD_KRD(!(HALF), u, 0); AD_GAPB(o[0] = AH_MFMA(AD_VFR(1), AD_PAF(1), o[0]), true, C0, 8);  AD_KRD(!(HALF), u, 1); AD_GAPB(o[1] = AH_MFMA(AD_VFR(5), AD_PAF(1), o[1]), true, C0, 12); \
    AD_KRD(!(HALF), u, 2); AD_GAPB(o[0] = AH_MFMA(AD_VFR(2), AD_PAF(2), o[0]), !(HALF), C1, 0);  AD_KRD(!(HALF), u, 3); AD_GAPB(o[1] = AH_MFMA(AD_VFR(6), AD_PAF(2), o[1]), !(HALF), C1, 4); \
    AD_GAPB(o[0] = AH_MFMA(AD_VFR(3), AD_PAF(3), o[0]), !(HALF), C1, 8);                   AD_GAPB(o[1] = AH_MFMA(AD_VFR(7), AD_PAF(3), o[1]), !(HALF), C1, 12); \
  } while (0)
  asm volatile("s_waitcnt vmcnt(0) lgkmcnt(0)\n\ts_barrier" ::: "memory");
#pragma unroll
  for (int d0 = 0; d0 < 4; ++d0) ad_kload2(kf, kp0, d0);
  AD_INIT(pA0, 0, 0, 0.f); AD_INIT(pA1, 0, 32, 0.f);
  pA0 = AH_MFMA(kf[0], qr[0], pA0); pA1 = AH_MFMA(kf[1], qr[0], pA1); pA0 = AH_MFMA(kf[2], qr[1], pA0); pA1 = AH_MFMA(kf[3], qr[1], pA1);
  pA0 = AH_MFMA(kf[4], qr[2], pA0); pA1 = AH_MFMA(kf[5], qr[2], pA1); pA0 = AH_MFMA(kf[6], qr[3], pA0); pA1 = AH_MFMA(kf[7], qr[3], pA1);
  {
    const int klo = (r32 > lb ? r32 : lb) - 4 * hi;
    ad_lmask(pA0, klo, 0);
    if (lb > 32) ad_lmask(pA1, klo, 32);
    const float rm = ah_rowmax(pA0, pA1);
    mhat = __builtin_fmaxf(rm, -1000.0f);
    const float nm0 = -mhat;
#pragma unroll
    for (int r = 0; r < 16; ++r) { pA0[r] = __builtin_amdgcn_exp2f(pA0[r] + nm0); pA1[r] = __builtin_amdgcn_exp2f(pA1[r] + nm0); }
  }
#pragma unroll
  for (int d0 = 0; d0 < 4; ++d0) ad_kload2(kf, kp0 + 1024, d0);
  AD_STEP(pB0, pB1, pA0, pA1, 1, false); AD_RESC();
  AD_STEP(pA0, pA1, pB0, pB1, 2, true);  AD_RESC();
  {
    float sacc = pA0[0] + pA0[1];
#pragma unroll
    for (int r = 2; r < 16; ++r) sacc += pA0[r];
    l_reg += sacc;
    pw0 = (u32x4){AD_PKW(pA0, 0), AD_PKW(pA0, 2), AD_PKW(pA0, 4), AD_PKW(pA0, 6)}; pw1 = (u32x4){AD_PKW(pA0, 8), AD_PKW(pA0, 10), AD_PKW(pA0, 12), AD_PKW(pA0, 14)};
    const ah_lds_cptr vp_ = vp0 + 2 * 4096;
    AD_VRD(0); AD_VRD(4); AD_VRD(1); AD_VRD(5);
    o[0] = AH_MFMA(AD_VFR(0), AD_PAF(0), o[0]); o[1] = AH_MFMA(AD_VFR(4), AD_PAF(0), o[1]); o[0] = AH_MFMA(AD_VFR(1), AD_PAF(1), o[0]); o[1] = AH_MFMA(AD_VFR(5), AD_PAF(1), o[1]);
  }
  const float ltot = l_reg + __shfl_xor(l_reg, 32);
  const float inv = 1.0f / ltot;
  bf16_t* dst = p.DILO + ((size_t)c * T_TOK + tok) * 384 + hd * 64;
  if (hi == 0) p.LSE2[((size_t)c * T_TOK + tok) * 6 + hd] = mhat + __builtin_amdgcn_logf(ltot);
#pragma unroll
  for (int dt = 0; dt < 2; ++dt)
#pragma unroll
    for (int gq = 0; gq < 4; ++gq) {
      uint2 ov;
      ov.x = pack2(o[dt][4 * gq + 0] * inv, o[dt][4 * gq + 1] * inv);
      ov.y = pack2(o[dt][4 * gq + 2] * inv, o[dt][4 * gq + 3] * inv);
      *(uint2*)(dst + 32 * dt + 8 * gq + 4 * hi) = ov;
    }
  asm volatile("s_waitcnt lgkmcnt(0)\n\ts_barrier" ::: "memory");
#undef AD_INIT
#undef AD_RESC
#undef AD_PKW
#undef AD_PAF
#undef AD_VFR
#undef AD_VRD
#undef AD_KRD
#undef AD_GAPA
#undef AD_GAPB
#undef AD_MF
#undef AD_STEP
}

DI void phase_attn_mfma(const int tid_, const Params& p, int bid, int nblk, char* lds, int PARTS = 7) {
  const int x = bid & 7, j = bid >> 3, nb = nblk >> 3;
  const int n_moba = 12 * 16, n_mem = NB * 4 * 16 / 8, n_dil = 12 * 48;
  const int total = n_moba + n_mem + n_dil;
  for (int k = 0; k * nb < (PROBE_TYPE ? 2 : 1) * total; ++k) {
    int li = k * nb + ((k & 1) ? (nb - 1 - j) : j);
    if (PROBE_TYPE && li >= total) { li -= total; PARTS = PROBE_TYPE; }
    if (li >= total) continue;
    if (li < n_moba) {
      if (!(PARTS & 1)) continue;
      const int m = 15 - (li & 15), bh = (li >> 4) * 8 + x;
      attn_unit_hi<2>(tid_, p, lds, bh / 6, bh % 6, m);
    } else if (li < n_moba + n_mem) {
      if (!(PARTS & 2)) continue;
      const int it = (li - n_moba) * 8 + x;
      attn_unit_hi<0>(tid_, p, lds, it >> 6, (it >> 4) & 3, it & 15);
    } else {
      if (!(PARTS & 4)) continue;
      const int it = li - n_moba - n_mem;
      const int q = it % 48, bh = (it / 48) * 8 + x;
      int c, m, res;
      if (q < 16) { c = 0; m = q; res = 0; }
      else if (q < 32) { c = 1; m = (q - 16) & 3; res = (q - 16) >> 2; }
      else { c = 2; m = 0; res = q - 32; }
      attn_unit_dil(tid_, p, lds, bh / 6, bh % 6, m, c, res);
    }
  }
}

DI void groupnorm_rows(const int tid_, const Params& p, int row0, int nrows, int gw, int nw) {
  const int lane = tid_ & 63;
  const int grp = lane < 24 ? 0 : (lane < 48 ? 1 : 2);
  const float* gp = grp == 0 ? p.og_dil + lane * 16 : (grp == 1 ? p.og_moba + (lane - 24) * 16 : p.og_mem + (lane - 48) * 16);
  const float inv_n = grp == 2 ? 1.0f / 256.0f : 1.0f / 384.0f;
  for (int row = row0 + gw; row < row0 + nrows; row += nw) {
    bf16_t* yp = p.HN + (size_t)row * DM + lane * 16;
    const uint4 a = ((const uint4*)yp)[0], b = ((const uint4*)yp)[1];
    const unsigned w[8] = {a.x, a.y, a.z, a.w, b.x, b.y, b.z, b.w};
    float v[16];
#pragma unroll
    for (int j = 0; j < 8; ++j) { v[2 * j] = __uint_as_float(w[j] << 16); v[2 * j + 1] = __uint_as_float(w[j] & 0xffff0000u); }
    if (grp == 0) {
      float ls[3];
#pragma unroll
      for (int c = 0; c < 3; ++c) ls[c] = p.LSE2[((size_t)c * T_TOK + row) * 6 + (lane >> 2)];
      const float M = fmaxf(ls[0], fmaxf(ls[1], ls[2]));
      float wc[3], wsum = 0.f;
#pragma unroll
      for (int c = 0; c < 3; ++c) { wc[c] = __builtin_amdgcn_exp2f(ls[c] - M); wsum += wc[c]; }
      const float winv = 1.0f / wsum;
#pragma unroll
      for (int j = 0; j < 16; ++j) v[j] = 0.f;
#pragma unroll
      for (int c = 0; c < 3; ++c) {
        const bf16_t* dp = p.DILO + ((size_t)c * T_TOK + row) * 384 + lane * 16;
        const uint4 da = ((const uint4*)dp)[0], db = ((const uint4*)dp)[1];
        const unsigned dw[8] = {da.x, da.y, da.z, da.w, db.x, db.y, db.z, db.w};
        const float wgt = wc[c] * winv;
#pragma unroll
        for (int j = 0; j < 8; ++j) { v[2 * j] += wgt * __uint_as_float(dw[j] << 16); v[2 * j + 1] += wgt * __uint_as_float(dw[j] & 0xffff0000u); }
      }
    }
    float ss = 0.f;
#pragma unroll
    for (int j = 0; j < 16; ++j) ss += v[j] * v[j];
    const float s0 = wave_sum(grp == 0 ? ss : 0.f), s1 = wave_sum(grp == 1 ? ss : 0.f), s2 = wave_sum(grp == 2 ? ss : 0.f);
    const float tot = grp == 0 ? s0 : (grp == 1 ? s1 : s2);
    const float rinv = rsqrtf(tot * inv_n + 1e-6f);
    unsigned o[8];
#pragma unroll
    for (int j = 0; j < 8; ++j) o[j] = pack2(v[2 * j] * rinv * gp[2 * j], v[2 * j + 1] * rinv * gp[2 * j + 1]);
    ((uint4*)yp)[0] = make_uint4(o[0], o[1], o[2], o[3]);
    ((uint4*)yp)[1] = make_uint4(o[4], o[5], o[6], o[7]);
  }
}

struct CandTab { int a[64], b[64]; };
constexpr CandTab make_cand() {
  CandTab t{};
  int cnt = 0;
  for (int a = 0; a < 16; ++a)
    for (int b = 0; b < 16; ++b)
      if ((a + 1) * (b + 1) <= 16) { t.a[cnt] = a; t.b[cnt] = b; ++cnt; }
  for (; cnt < 64; ++cnt) { t.a[cnt] = 0; t.b[cnt] = 0; }
  return t;
}
DI unsigned f2key(float f) { const unsigned u = __float_as_uint(f); return u ^ ((unsigned)((int)u >> 31) | 0x80000000u); }
DI float key2f(unsigned k) { const unsigned u = (k & 0x80000000u) ? (k ^ 0x80000000u) : ~k; return __uint_as_float(u); }
DI void cex_desc(unsigned& a, unsigned& b) { const unsigned hi = a > b ? a : b, lo = a > b ? b : a; a = hi; b = lo; }
DI void sort16_desc(unsigned (&a)[16]) {
#pragma unroll
  for (int k = 2; k <= 16; k <<= 1)
#pragma unroll
    for (int j = k >> 1; j >= 1; j >>= 1)
#pragma unroll
      for (int i = 0; i < 16; ++i) {
        const int l = i ^ j;
        if (l > i) { if ((i & k) == 0) cex_desc(a[i], a[l]); else cex_desc(a[l], a[i]); }
      }
}
DI void bitonic_merge16_desc(unsigned (&a)[16]) {
#pragma unroll
  for (int j = 8; j >= 1; j >>= 1)
#pragma unroll
    for (int i = 0; i < 16; ++i) { const int l = i ^ j; if (l > i) cex_desc(a[i], a[l]); }
}
DI void merge_top16(unsigned (&L)[16], const unsigned (&S)[16]) {
#pragma unroll
  for (int i = 0; i < 16; ++i) L[i] = L[i] > S[15 - i] ? L[i] : S[15 - i];
  bitonic_merge16_desc(L);
}

DI void peerq_scores_topk(const int tid_, const char* SKl, const f32x16 (&acc)[4], unsigned (&L)[16]) {
  const int lane = tid_ & 63, r = lane & 31, h = lane >> 5;
  bf16x8 xf[4][2];
#pragma unroll
  for (int nt = 0; nt < 4; ++nt)
#pragma unroll
    for (int s2 = 0; s2 < 2; ++s2) {
      u32x4 pk;
#pragma unroll
      for (int j = 0; j < 4; ++j) pk[j] = pack2(acc[nt][8 * s2 + 2 * j], acc[nt][8 * s2 + 2 * j + 1]);
      xf[nt][s2] = __builtin_bit_cast(bf16x8, pk);
    }
#pragma unroll
  for (int j = 0; j < 16; ++j) L[j] = 0u;
#pragma unroll 1
  for (int kt = 0; kt < 4; ++kt) {
    f32x16 sc;
#pragma unroll
    for (int i = 0; i < 16; ++i) sc[i] = 0.f;
    const char* krow = SKl + (32 * kt + r) * 256;
    const int ksw = r & 15;
#pragma unroll
    for (int nt = 0; nt < 4; ++nt)
#pragma unroll
      for (int s2 = 0; s2 < 2; ++s2) {
        const u32x4 kk = *(const u32x4*)(krow + ((((nt * 2 + s2) * 2 + h) ^ ksw) << 4));
        sc = __builtin_amdgcn_mfma_f32_32x32x16_bf16(__builtin_bit_cast(bf16x8, kk), xf[nt][s2], sc, 0, 0, 0);
      }
    unsigned S[16];
#pragma unroll
    for (int i = 0; i < 16; ++i) {
      const unsigned idx = (unsigned)(32 * kt + (i & 3) + 8 * (i >> 2) + 4 * h);
      S[i] = (f2key(sc[i]) & 0xffffff80u) | idx;
    }
    sort16_desc(S);
    if (kt == 0) {
#pragma unroll
      for (int j = 0; j < 16; ++j) L[j] = S[j];
    } else merge_top16(L, S);
  }
  unsigned P[16];
#pragma unroll
  for (int j = 0; j < 16; ++j) {
    auto rr = __builtin_amdgcn_permlane32_swap(L[j], L[j], false, false);
    L[j] = rr[0]; P[j] = rr[1];
  }
  merge_top16(L, P);
}

DI void peerq_item(const int tid_, const Params& p, char* lds, int mt, int head) {
  const int tid = tid_, lane = tid & 63, w = tid >> 6, r = lane & 31, h = lane >> 5;
  f32x16 acc[8];
#pragma unroll
  for (int a = 0; a < 8; ++a)
#pragma unroll
    for (int i = 0; i < 16; ++i) acc[a][i] = 0.f;
  unsigned loff[4];
#pragma unroll
  for (int j = 0; j < 4; ++j) {
    const int row = 32 * w + 8 * j + (lane >> 3);
    loff[j] = (unsigned)((row * DM + (((lane & 7) ^ ((row >> 1) & 7)) << 3)) * 2);
  }
  const int wave_s = __builtin_amdgcn_readfirstlane(w);
  const unsigned lds0 = (unsigned)(size_t)lds + (unsigned)(wave_s * 32 * 128);
  const char* Ab = (const char*)(p.HN + (size_t)(mt * 256) * DM);
  const char* Bb = (const char*)(p.WqT + (size_t)(head * 256) * DM);
  asm volatile("s_waitcnt vmcnt(0)" ::: "memory");
  __syncthreads();
#pragma unroll
  for (int j = 0; j < 4; ++j) { dma16_saddr(Ab, loff[j], lds0 + j * 1024); dma16_saddr(Bb, loff[j], lds0 + 32768 + j * 1024); }
  const unsigned sk_lds = (unsigned)(size_t)lds + (unsigned)(wave_s * 4096);
  {
    int l2 = lane; asm volatile("" : "+v"(l2));
    const bf16_t* sub1 = karg()->SUB1;
#pragma unroll
    for (int j = 0; j < 4; ++j) {
      const int pc = (wave_s * 4 + j) * 64 + l2, row = pc >> 4;
      dma16_saddr(sub1 + (size_t)head * 128 * 128, (unsigned)(row * 256 + (((pc & 15) ^ (row & 15)) << 4)), sk_lds + 2 * BIG_STAGE_BYTES + j * 1024);
    }
  }
  const int trow = 32 * w + r;
  const int toff = trow * 128, tsw = (trow >> 1) & 7, wsw = (r >> 1) & 7;
  for (int kt = 0; kt < 16; ++kt) {
    asm volatile("s_waitcnt vmcnt(0) lgkmcnt(0)" ::: "memory");
    __builtin_amdgcn_s_barrier();
    const char* Sc = lds + (kt & 1) * BIG_STAGE_BYTES;
    const unsigned ldn = lds0 + (unsigned)(((kt + 1) & 1) * BIG_STAGE_BYTES);
    const bool more = kt + 1 < 16;
    const char* An = Ab + (size_t)(kt + 1) * 128;
    const char* Bn = Bb + (size_t)(kt + 1) * 128;
#pragma unroll
    for (int s = 0; s < 4; ++s) {
      const bf16x8 tf = *(const bf16x8*)(Sc + toff + (((2 * s + h) ^ tsw) << 4));
      bf16x8 wf[4], wg[4];
#pragma unroll
      for (int nt = 0; nt < 4; ++nt) wf[nt] = *(const bf16x8*)(Sc + 32768 + (32 * nt + r) * 128 + (((2 * s + h) ^ wsw) << 4));
      if (more && s < 2) {
        dma16_saddr(An, loff[2 * s], ldn + (2 * s) * 1024); dma16_saddr(Bn, loff[2 * s], ldn + 32768 + (2 * s) * 1024);
        dma16_saddr(An, loff[2 * s + 1], ldn + (2 * s + 1) * 1024); dma16_saddr(Bn, loff[2 * s + 1], ldn + 32768 + (2 * s + 1) * 1024);
      }
#pragma unroll
      for (int nt = 0; nt < 4; ++nt) wg[nt] = *(const bf16x8*)(Sc + 32768 + (32 * (nt + 4) + r) * 128 + (((2 * s + h) ^ wsw) << 4));
#pragma unroll
      for (int nt = 0; nt < 4; ++nt) acc[nt] = __builtin_amdgcn_mfma_f32_32x32x16_bf16(wf[nt], tf, acc[nt], 0, 0, 0);
#pragma unroll
      for (int nt = 0; nt < 4; ++nt) acc[nt + 4] = __builtin_amdgcn_mfma_f32_32x32x16_bf16(wg[nt], tf, acc[nt + 4], 0, 0, 0);
      __builtin_amdgcn_sched_barrier(0);
    }
  }
  __syncthreads();
  {
    int l2 = lane; asm volatile("" : "+v"(l2));
    const bf16_t* sub2 = karg()->SUB2;
#pragma unroll
    for (int j = 0; j < 4; ++j) {
      const int pc = (wave_s * 4 + j) * 64 + l2, row = pc >> 4;
      dma16_saddr(sub2 + (size_t)head * 128 * 128, (unsigned)(row * 256 + (((pc & 15) ^ (row & 15)) << 4)), sk_lds + BIG_STAGE_BYTES + j * 1024);
    }
  }
  unsigned L0[16], L[16];
  {
    const f32x16 (&a0)[4] = *(const f32x16 (*)[4])&acc[0];
    peerq_scores_topk(tid_, lds + 2 * BIG_STAGE_BYTES, a0, L0);
    asm volatile("s_waitcnt vmcnt(0)" ::: "memory");
    __syncthreads();
    const f32x16 (&a1)[4] = *(const f32x16 (*)[4])&acc[4];
    peerq_scores_topk(tid_, lds + BIG_STAGE_BYTES, a1, L);
  }
  unsigned* stash0 = (unsigned*)lds + (32 * w + r) * 64 + 32 * h;
  unsigned* stash1 = stash0 + 16;
#pragma unroll
  for (int j = 0; j < 4; ++j) {
    *(u32x4*)(stash0 + 4 * j) = (u32x4){L0[4 * j], L0[4 * j + 1], L0[4 * j + 2], L0[4 * j + 3]};
    *(u32x4*)(stash1 + 4 * j) = (u32x4){L[4 * j], L[4 * j + 1], L[4 * j + 2], L[4 * j + 3]};
  }
  {
    float v1[16], v2[16];
#pragma unroll
    for (int j = 0; j < 16; ++j) { v1[j] = key2f(L0[j] & 0xffffff80u); v2[j] = key2f(L[j] & 0xffffff80u); }
    unsigned F[16], G[16];
#pragma unroll
    for (int gi = 0; gi < 2; ++gi) {
#pragma unroll
      for (int jj = 0; jj < 16; ++jj) {
        constexpr CandTab ct = make_cand();
        const int c0 = 16 * gi + jj, c1 = 16 * (gi + 2) + jj;
        const int a0 = ct.a[c0], b0 = ct.b[c0];
        const bool ok1 = c1 < 50;
        const int a1 = ok1 ? ct.a[c1] : a0, b1 = ok1 ? ct.b[c1] : b0;
        const float x1 = h ? v1[a1] : v1[a0], x2 = h ? v2[b1] : v2[b0];
        const unsigned is = h ? (unsigned)(a1 * 16 + b1) : (unsigned)(a0 * 16 + b0);
        const unsigned key = (f2key(x1 + x2) & 0xffffff00u) | is;
        G[jj] = ok1 ? key : (h ? 0u : key);
      }
      sort16_desc(G);
      if (gi == 0) {
#pragma unroll
        for (int jj = 0; jj < 16; ++jj) F[jj] = G[jj];
      } else merge_top16(F, G);
    }
#pragma unroll
    for (int jj = 0; jj < 16; ++jj) {
      auto rr = __builtin_amdgcn_permlane32_swap(F[jj], F[jj], false, false);
      F[jj] = rr[0]; G[jj] = rr[1];
    }
    merge_top16(F, G);
    const float mx = key2f(F[0] & 0xffffff00u);
    float e[16], den = 0.f;
    int ex[16];
#pragma unroll
    for (int j = 0; j < 16; ++j) {
      e[j] = __expf(key2f(F[j] & 0xffffff00u) - mx);
      den += e[j];
      const int a = (F[j] >> 4) & 15, b = F[j] & 15;
      const unsigned k1 = stash0[a], k2 = stash1[b];
      ex[j] = (int)((k1 & 127u) * 128u + (k2 & 127u));
    }
    const float inv = 1.0f / den;
    if (h == 0) {
      const size_t o = (size_t)(mt * 256 + 32 * w + r) * 128 + head * 16;
#pragma unroll
      for (int j = 0; j < 2; ++j)
        *(u32x4*)(p.PIDX + o + 8 * j) = (u32x4){(unsigned)ex[8 * j] | ((unsigned)ex[8 * j + 1] << 16), (unsigned)ex[8 * j + 2] | ((unsigned)ex[8 * j + 3] << 16),
                                                (unsigned)ex[8 * j + 4] | ((unsigned)ex[8 * j + 5] << 16), (unsigned)ex[8 * j + 6] | ((unsigned)ex[8 * j + 7] << 16)};
#pragma unroll
      for (int j = 0; j < 4; ++j)
        *(float4*)(p.PGATE + o + 4 * j) = make_float4(e[4 * j] * inv, e[4 * j + 1] * inv, e[4 * j + 2] * inv, e[4 * j + 3] * inv);
    }
  }
}

template <int CTRL>
DI int dpp_addi(int v) { return v + __builtin_amdgcn_update_dpp(0, v, CTRL, 0xf, 0xf, true); }
DI void phase_peer_u(const int tid_, const Params& p, int bid, int nblk) {
  const int lane = tid_ & 63, w = tid_ >> 6, g = lane >> 3, l8 = lane & 7;
  const int k = bid & 7, ws = (bid >> 3) * WPB + w, nws = (nblk >> 3) * WPB;
  const uint8_t* Us = p.U8s + (size_t)k * 16384 * 128;
  const unsigned lo16 = 16u * (unsigned)l8;
  bf16_t* PPk = (bf16_t*)p.PP + (size_t)k * T_TOK * 128;
  for (int G = ws; G < T_TOK / 8; G += nws) {
    const int t = 8 * G + g;
    const u32x4 xq = *(const u32x4*)(p.X8 + ((size_t)k * T_TOK + t) * 128 + 16 * l8);
    const float sx = p.SX[(size_t)t * 8 + k];
    const unsigned short* ip = p.PIDX + (size_t)t * 128;
#pragma unroll 1
    for (int c = 0; c < 8; ++c) {
      int idx[16];
#pragma unroll
      for (int j = 0; j < 2; ++j) {
        const u32x4 q = *(const u32x4*)(ip + 16 * c + 8 * j);
#pragma unroll
        for (int e = 0; e < 4; ++e) { idx[8 * j + 2 * e] = (int)(q[e] & 0xffffu); idx[8 * j + 2 * e + 1] = (int)(q[e] >> 16); }
      }
      u32x4 u[16];
#pragma unroll
      for (int i = 0; i < 16; ++i) u[i] = *(const u32x4*)(Us + (((unsigned)idx[i] << 7) + lo16));
      int o0 = 0, o1 = 0;
#pragma unroll
      for (int i = 0; i < 16; ++i) {
        int acc = 0;
#pragma unroll
        for (int d = 0; d < 4; ++d) acc = __builtin_amdgcn_sdot4((int)u[i][d], (int)xq[d], acc, false);
        acc = dpp_addi<0xB1>(acc);
        acc = dpp_addi<0x4E>(acc);
        acc = dpp_addi<0x141>(acc);
        if ((i >> 1) == l8) { if (i & 1) o1 = acc; else o0 = acc; }
      }
      *(unsigned*)(PPk + (size_t)t * 128 + 16 * c + 2 * l8) = pack2((float)o0 * sx, (float)o1 * sx);
    }
  }
}

DI void phase_peer_w(const int tid_, const Params& p, int bid, int nblk) {
  const int gt = bid * NTHREADS + tid_, nt = nblk * NTHREADS;
  for (int i = gt; i < T_TOK * 128 / 4; i += nt) {
    float4 s = make_float4(0.f, 0.f, 0.f, 0.f);
#pragma unroll
    for (int k = 0; k < 8; ++k) {
      const uint2 q = ((const uint2*)((const bf16_t*)p.PP + (size_t)k * T_TOK * 128))[i];
      s.x += __uint_as_float(q.x << 16); s.y += __uint_as_float(q.x & 0xffff0000u);
      s.z += __uint_as_float(q.y << 16); s.w += __uint_as_float(q.y & 0xffff0000u);
    }
    const float4 gte = ((const float4*)p.PGATE)[i];
    const uint2 ei = ((const uint2*)p.PIDX)[i];
    const int e4[4] = {(int)(ei.x & 0xffffu), (int)(ei.x >> 16), (int)(ei.y & 0xffffu), (int)(ei.y >> 16)};
    float a[4] = {s.x, s.y, s.z, s.w}, gg[4] = {gte.x, gte.y, gte.z, gte.w}, o[4];
    float mx = 0.f;
#pragma unroll
    for (int j = 0; j < 4; ++j) {
      const float v = a[j] * p.SU[e4[j]];
      o[j] = 0.5f * v * (1.0f + erff(v * 0.70710678118654752f)) * gg[j] * p.SV[e4[j]];
      mx = fmaxf(mx, fabsf(o[j]));
    }
    mx = max32(mx);
    const float inv = mx > 0.f ? 127.0f / mx : 0.f;
    const unsigned q = ((unsigned)__float2int_rn(o[0] * inv) & 0xffu) | (((unsigned)__float2int_rn(o[1] * inv) & 0xffu) << 8) |
                       (((unsigned)__float2int_rn(o[2] * inv) & 0xffu) << 16) | (((unsigned)__float2int_rn(o[3] * inv) & 0xffu) << 24);
    const int t = i >> 5;
    ((unsigned*)(p.PGATE + (size_t)t * 128))[i & 31] = q;
    if ((i & 31) == 0) p.SW[t] = mx * (1.0f / 127.0f);
  }
}

DI unsigned perm_b32(unsigned hi, unsigned lo, unsigned sel) { return __builtin_amdgcn_perm(hi, lo, sel); }
DI void phase_peer_v(const int tid_, const Params& p, int bid, int nblk) {
  const int lane = tid_ & 63, w = tid_ >> 6, g = lane >> 3, l8 = lane & 7;
  const int k = bid & 7, ws = (bid >> 3) * WPB + w, nws = (nblk >> 3) * WPB;
  const uint8_t* Vs = p.V8s + (size_t)k * 16384 * 128;
  const unsigned lo16 = 16u * (unsigned)l8;
  for (int G = ws; G < T_TOK / 8; G += nws) {
    const int t = 8 * G + g;
    const unsigned short* ip = p.PIDX + (size_t)t * 128;
    const unsigned* wq = (const unsigned*)(p.PGATE + (size_t)t * 128);
    const float sw = p.SW[t];
    int acc[16];
#pragma unroll
    for (int j = 0; j < 16; ++j) acc[j] = 0;
#pragma unroll 1
    for (int c = 0; c < 8; ++c) {
      int idx[16];
#pragma unroll
      for (int j = 0; j < 2; ++j) {
        const u32x4 q = *(const u32x4*)(ip + 16 * c + 8 * j);
#pragma unroll
        for (int e = 0; e < 4; ++e) { idx[8 * j + 2 * e] = (int)(q[e] & 0xffffu); idx[8 * j + 2 * e + 1] = (int)(q[e] >> 16); }
      }
      const u32x4 w4 = *(const u32x4*)(wq + 4 * c);
      u32x4 v[16];
#pragma unroll
      for (int i = 0; i < 16; ++i) v[i] = *(const u32x4*)(Vs + (((unsigned)idx[i] << 7) + lo16));
#pragma unroll
      for (int q4 = 0; q4 < 4; ++q4) {
#pragma unroll
        for (int d = 0; d < 4; ++d) {
          const unsigned x0 = v[4 * q4][d], x1 = v[4 * q4 + 1][d], x2 = v[4 * q4 + 2][d], x3 = v[4 * q4 + 3][d];
          const unsigned t01l = perm_b32(x1, x0, 0x05010400u);
          const unsigned t01h = perm_b32(x1, x0, 0x07030602u);
          const unsigned t23l = perm_b32(x3, x2, 0x05010400u);
          const unsigned t23h = perm_b32(x3, x2, 0x07030602u);
          const unsigned y0 = perm_b32(t23l, t01l, 0x05040100u);
          const unsigned y1 = perm_b32(t23l, t01l, 0x07060302u);
          const unsigned y2 = perm_b32(t23h, t01h, 0x05040100u);
          const unsigned y3 = perm_b32(t23h, t01h, 0x07060302u);
          acc[4 * d + 0] = __builtin_amdgcn_sdot4((int)y0, (int)w4[q4], acc[4 * d + 0], false);
          acc[4 * d + 1] = __builtin_amdgcn_sdot4((int)y1, (int)w4[q4], acc[4 * d + 1], false);
          acc[4 * d + 2] = __builtin_amdgcn_sdot4((int)y2, (int)w4[q4], acc[4 * d + 2], false);
          acc[4 * d + 3] = __builtin_amdgcn_sdot4((int)y3, (int)w4[q4], acc[4 * d + 3], false);
        }
      }
    }
    float4* op = (float4*)(p.out + (size_t)t * DM + 128 * k + 16 * l8);
    const u32x4* xp = (const u32x4*)(X1B(p) + (size_t)t * DM + 128 * k + 16 * l8);
    const u32x4 xa = xp[0], xb = xp[1];
    const unsigned xw[8] = {xa[0], xa[1], xa[2], xa[3], xb[0], xb[1], xb[2], xb[3]};
#pragma unroll
    for (int j = 0; j < 4; ++j) {
      float4 o;
      o.x = __uint_as_float(xw[2 * j] << 16) + sw * (float)acc[4 * j];
      o.y = __uint_as_float(xw[2 * j] & 0xffff0000u) + sw * (float)acc[4 * j + 1];
      o.z = __uint_as_float(xw[2 * j + 1] << 16) + sw * (float)acc[4 * j + 2];
      o.w = __uint_as_float(xw[2 * j + 1] & 0xffff0000u) + sw * (float)acc[4 * j + 3];
      op[j] = o;
    }
  }
}

#define XB_TMO      128
#define XB_XCNT(j)  (256  + 64 * (j))
#define XB_XSUB(j)  (1280 + 64 * (j))
#define XB_XGEN(j)  (2304 + 64 * (j))
#define XB_TOP      3328
#define XB_TOPGEN   3392
#define XCD_BAR_WORDS 3456
#define XB_SPIN_CAP (1u << 20)
#define LAS __attribute__((address_space(3)))
DI unsigned xb_ld(unsigned* p) { return __hip_atomic_load(p, __ATOMIC_RELAXED, __HIP_MEMORY_SCOPE_AGENT); }
DI unsigned xb_add(unsigned* p, unsigned v) { return __hip_atomic_fetch_add(p, v, __ATOMIC_RELAXED, __HIP_MEMORY_SCOPE_AGENT); }
DI unsigned xb_xcc_id() { return (unsigned)__builtin_amdgcn_s_getreg((3 << 11) | 20) & 0xFu; }
#define XB_SPIN(cond, bar) do { unsigned _sp = 0; while (cond) { __builtin_amdgcn_s_sleep(1); \
    if ((++_sp & 255u) == 0u) { if (xb_ld(&(bar)[XB_TMO])) break; if (_sp > XB_SPIN_CAP) { atomicAdd(&(bar)[XB_TMO], 1u); break; } } } } while (0)
struct XcdBarrier { unsigned packed; };
DI XcdBarrier xcd_barrier_post(const int tid_, unsigned* bar) {
  XcdBarrier b; b.packed = xb_xcc_id();
  if (tid_ == 0) (void)xb_add(&bar[XB_XCNT(b.packed)], 1u);
  return b;
}
DI void xcd_barrier_complete(unsigned* bar, unsigned x, unsigned& nloc, unsigned& nx) {
  const unsigned G = gridDim.x * gridDim.y * gridDim.z;
  unsigned sum, cnt, mine, sp = 0u;
  for (;;) {
    sum = 0u; cnt = 0u; mine = 0u;
#pragma unroll
    for (unsigned j = 0; j < 16; ++j) { const unsigned c = xb_ld(&bar[XB_XCNT(j)]); sum += c; cnt += (c > 0u) ? 1u : 0u; mine = (j == x) ? c : mine; }
    if (sum == G) break;
    __builtin_amdgcn_s_sleep(1);
    if ((++sp & 255u) == 0u) { if (xb_ld(&bar[XB_TMO])) break; if (sp > XB_SPIN_CAP) { atomicAdd(&bar[XB_TMO], 1u); break; } }
  }
  nloc = mine > 0u ? mine : 1u; nx = cnt > 0u ? cnt : 1u;
}
DI void xcd_barrier(const int tid_, XcdBarrier& b) {
  unsigned* bar = karg()->bar;
  asm volatile("s_waitcnt vmcnt(0)" ::: "memory");
  __syncthreads();
  if ((b.packed >> 9) == 0u) {
    unsigned nl, nxx;
    xcd_barrier_complete(bar, b.packed & 15u, nl, nxx);
    b.packed = (unsigned)__builtin_amdgcn_readfirstlane((int)((b.packed & 15u) | (nxx << 4) | (nl << 9)));
  }
  if (tid_ == 0) {
    __builtin_amdgcn_s_waitcnt(0);
    const unsigned x = b.packed & 15u, nx = (b.packed >> 4) & 31u, nloc = b.packed >> 9;
    const unsigned old = xb_add(&bar[XB_XSUB(x)], 1u);
    const unsigned gen = old / nloc;
    if (old + 1u == (gen + 1u) * nloc) {
      __builtin_amdgcn_fence(__ATOMIC_RELEASE, "agent");
      asm volatile("s_waitcnt vmcnt(0)" ::: "memory");
      const unsigned og = xb_add(&bar[XB_TOP], 1u);
      const unsigned tg = og / nx;
      if (og + 1u == (tg + 1u) * nx) xb_add(&bar[XB_TOPGEN], 1u);
      else XB_SPIN(xb_ld(&bar[XB_TOPGEN]) == tg, bar);
      __builtin_amdgcn_fence(__ATOMIC_ACQUIRE, "agent");
      xb_add(&bar[XB_XGEN(x)], 1u);
      asm volatile("s_waitcnt vmcnt(0)" ::: "memory");
    } else {
      XB_SPIN(xb_ld(&bar[XB_XGEN(x)]) == gen, bar);
      __builtin_amdgcn_fence(__ATOMIC_ACQUIRE, "agent");
      asm volatile("s_waitcnt vmcnt(0)" ::: "memory");
    }
  }
  __syncthreads();
}

DI void norm2_rows(const int tid_, const Params& p, int row0, int nrows, int gw, int nw) {
  const int lane = tid_ & 63;
  for (int row = row0 + gw; row < row0 + nrows; row += nw) {
    const uint2* s2 = (const uint2*)(X1B(p) + (size_t)row * DM);
    float4 v[4];
    float ss = 0.f;
#pragma unroll
    for (int i = 0; i < 4; ++i) {
      const uint2 q2 = s2[lane + 64 * i];
      v[i] = make_float4(__uint_as_float(q2.x << 16), __uint_as_float(q2.x & 0xffff0000u), __uint_as_float(q2.y << 16), __uint_as_float(q2.y & 0xffff0000u));
      ss += v[i].x * v[i].x + v[i].y * v[i].y + v[i].z * v[i].z + v[i].w * v[i].w;
    }
    ss = wave_sum(ss);
    const float rinv = rsqrtf(ss * (1.0f / DM) + 1e-6f);
#pragma unroll
    for (int i = 0; i < 4; ++i) {
      const float4 gg = ((const float4*)p.g_ffn)[lane + 64 * i];
      const float a = v[i].x * rinv * gg.x, b = v[i].y * rinv * gg.y, c = v[i].z * rinv * gg.z, d = v[i].w * rinv * gg.w;
      uint2 o;
      o.x = pack2(a, b); o.y = pack2(c, d);
      ((uint2*)(p.HN + (size_t)row * DM))[lane + 64 * i] = o;
      float mx = fmaxf(fmaxf(fabsf(a), fabsf(b)), fmaxf(fabsf(c), fabsf(d)));
      mx = max32(mx);
      const float inv = mx > 0.f ? 127.0f / mx : 0.f;
      const unsigned q = ((unsigned)__float2int_rn(a * inv) & 0xffu) | (((unsigned)__float2int_rn(b * inv) & 0xffu) << 8) |
                         (((unsigned)__float2int_rn(c * inv) & 0xffu) << 16) | (((unsigned)__float2int_rn(d * inv) & 0xffu) << 24);
      const int slice = 2 * i + (lane >> 5);
      *(unsigned*)(p.X8 + ((size_t)slice * T_TOK + row) * 128 + 4 * (lane & 31)) = q;
      if ((lane & 31) == 0) p.SX[(size_t)row * 8 + slice] = mx * (1.0f / 127.0f);
    }
  }
}

DI void phase_post(const int tid_, const Params& p, int bid, int nblk, char* lds) {
  for (int mt = bid; mt < T_TOK / 256; mt += nblk) {
    int ta = tid_; asm volatile("" : "+v"(ta));
    groupnorm_rows(ta, p, mt * 256, 256, ta >> 6, WPB);
    asm volatile("s_waitcnt vmcnt(0)" ::: "memory");
    __syncthreads();
    int tb = tid_; asm volatile("" : "+v"(tb));
#pragma unroll 1
    for (int nt_ = 0; nt_ < 4 * PP_OUT; ++nt_) {
      const int nt = nt_ & 3;
      f32x16 acc[4][2];
      gemm_big(tb, p.HN, p.WoutT, DM, mt * 256, nt * 256, lds, acc);
#pragma unroll 1
      for (int pass = 0; pass < 2; ++pass) {
        gemm_big_dump(tb, acc, pass, lds);
        const float* Cs = (const float*)lds;
#pragma unroll 2
        for (int it2 = 0; it2 < 16; ++it2) {
          const int task = tb + NTHREADS * it2;
          const int row = task >> 5, c4 = task & 31;
          const float4 c = *(const float4*)(Cs + row * 132 + c4 * 4);
          const size_t off = (size_t)(mt * 256 + row) * DM + nt * 256 + pass * 128 + c4 * 4;
          const float4 xv = *(const float4*)(p.x + off);
          uint2 o2; o2.x = pack2(xv.x + c.x, xv.y + c.y); o2.y = pack2(xv.z + c.z, xv.w + c.w);
          *(uint2*)(X1B(p) + off) = o2;
        }
      }
    }
    asm volatile("s_waitcnt vmcnt(0)" ::: "memory");
    __syncthreads();
    int tc = tid_; asm volatile("" : "+v"(tc));
#pragma unroll 1
    for (int rep_ = 0; rep_ < PP_N2; ++rep_) norm2_rows(tc, p, mt * 256, 256, tc >> 6, WPB);
    asm volatile("s_waitcnt vmcnt(0)" ::: "memory");
    __syncthreads();
#pragma unroll 1
    for (int head = 0; head < 8 * PP_PQ; ++head) { int td = tid_; asm volatile("" : "+v"(td)); peerq_item(td, p, lds, mt, head & 7); }
  }
}

#define NPHASE 7
template <int PH>
DI void run_phase(const int tid_, const Params& p, int bid, int nblk, char* lds, int parts = 7) {
  if (PH == 0) phase_prep(tid_, p, bid, nblk);
  if (PH == 1) phase_proj(tid_, p, bid, nblk, lds);
  if (PH == 2) phase_attn_mfma(tid_, p, bid, nblk, lds, parts);
  if (PH == 3) phase_post(tid_, p, bid, nblk, lds);
  if (PH == 4) phase_peer_u(tid_, p, bid, nblk);
  if (PH == 5) phase_peer_w(tid_, p, bid, nblk);
  if (PH == 6) phase_peer_v(tid_, p, bid, nblk);
}
template <int PH>
DI void mega_step(int bid, int nblk, char* lds, cg::grid_group& grid, XcdBarrier& xb, int wave_u) {
  unsigned z_ = 0u; asm volatile("" : "+v"(z_));
  int tid_ = wave_u * 64 + (int)__builtin_amdgcn_mbcnt_hi(~0u, __builtin_amdgcn_mbcnt_lo(~0u, z_));
  asm volatile("" : "+v"(tid_));
#if defined(__HIP_DEVICE_COMPILE__)
  KernargPtr pp = (KernargPtr)__builtin_amdgcn_kernarg_segment_ptr();
  asm volatile("" : "+s"(pp));
  const Params p = *pp;
#else
  const Params p{};
#endif
  if (DUP_PHASE == PH) {
    int nrep = 2; asm volatile("" : "+s"(nrep));
    for (int rep = 0; rep < nrep; ++rep) { if (rep) xcd_barrier(tid_, xb); run_phase<PH>(tid_, p, bid, nblk, lds, rep ? 7 : DUP_PARTS); }
  } else
#ifdef ONLY_PHASE
  if (PH == ONLY_PHASE)
#endif
  run_phase<PH>(tid_, p, bid, nblk, lds);
  if (PH == 0) grid.sync();
  else if (PH + 1 < NPHASE) xcd_barrier(tid_, xb);
}
__global__ void __launch_bounds__(NTHREADS, 2) mega(Params p0) {
  __shared__ __attribute__((aligned(16))) char lds[LDS_BYTES];
  const int bid = blockIdx.x, nblk = gridDim.x;
  cg::grid_group grid = cg::this_grid();
  const int tid_ = (int)__builtin_amdgcn_workitem_id_x();
  XcdBarrier xb = xcd_barrier_post(tid_, p0.bar);
  const int wave_u = __builtin_amdgcn_readfirstlane(tid_ >> 6);
  mega_step<0>(bid, nblk, lds, grid, xb, wave_u);
  mega_step<1>(bid, nblk, lds, grid, xb, wave_u);
  mega_step<2>(bid, nblk, lds, grid, xb, wave_u);
  mega_step<3>(bid, nblk, lds, grid, xb, wave_u);
  mega_step<4>(bid, nblk, lds, grid, xb, wave_u);
  mega_step<5>(bid, nblk, lds, grid, xb, wave_u);
  mega_step<6>(bid, nblk, lds, grid, xb, wave_u);
}

static inline size_t align_up(size_t v) { return (v + 255) & ~(size_t)255; }

extern "C" void kernel_launch(void* const* d_in, const int* in_sizes, int n_in, void* d_out, int out_size, void* d_ws,
                              size_t ws_size, hipStream_t stream) {
  Params p{};
  const float* const* in = (const float* const*)d_in;
  p.x = in[0]; p.mem = in[1]; p.g_mix = in[2]; p.w_in = in[3]; p.qg_dil = in[4]; p.kg_dil = in[5]; p.qg_moba = in[6];
  p.kg_moba = in[7]; p.qg_mem = in[8]; p.kg_mem = in[9]; p.g_memtok = in[10]; p.w_mem_kv = in[11]; p.og_dil = in[12];
  p.og_moba = in[13]; p.og_mem = in[14]; p.w_out = in[15]; p.g_ffn = in[16]; p.w_peer_q = in[17]; p.sub1 = in[18];
  p.sub2 = in[19]; p.peer_u = in[20]; p.peer_v = in[21];
  p.out = (float*)d_out;
  char* w = (char*)d_ws;
  size_t off = 0;
  auto take = [&](size_t bytes) { char* r = w + off; off = align_up(off + bytes); return r; };
  p.bar = (unsigned*)take((size_t)XCD_BAR_WORDS * 4);
  p.HN = (bf16_t*)take((size_t)T_TOK * DM * 2);
  p.QKV = (bf16_t*)take((size_t)NGRP * T_TOK * 64 * 2);
  p.MEMN = (bf16_t*)take((size_t)NB * MEMLEN * DM * 2);
  p.KVM = (bf16_t*)take((size_t)8 * NB * MEMLEN * 64 * 2);
  p.WinT = (bf16_t*)take((size_t)INW * DM * 2);
  p.WoutT = (bf16_t*)take((size_t)DM * DM * 2);
  p.WqT = (bf16_t*)take((size_t)2048 * DM * 2);
  p.WmkvT = (bf16_t*)take((size_t)512 * DM * 2);
  p.SUB1 = (bf16_t*)take((size_t)8 * 128 * 128 * 2);
  p.SUB2 = (bf16_t*)take((size_t)8 * 128 * 128 * 2);
  p.KMEAN = (float*)take((size_t)NB * 6 * 16 * 64 * 4);
  p.PIDX = (unsigned short*)take((size_t)T_TOK * 128 * 2);
  p.PGATE = (float*)take((size_t)T_TOK * 128 * 4);
  p.DILO = (bf16_t*)take((size_t)3 * T_TOK * 384 * 2);
  p.LSE2 = (float*)take((size_t)3 * T_TOK * 6 * 4);
  p.U8s = (uint8_t*)take((size_t)16384 * DM);
  p.V8s = (uint8_t*)take((size_t)16384 * DM);
  p.PP = (float*)p.QKV;
  p.SU = (float*)take((size_t)16384 * 4);
  p.SV = (float*)take((size_t)16384 * 4);
  p.SW = (float*)take((size_t)T_TOK * 4);
  p.X8 = (uint8_t*)p.DILO;
  p.SX = (float*)((char*)p.DILO + (size_t)T_TOK * DM);
  if (off > ws_size) { fprintf(stderr, "workspace too small: need %zu have %zu\n", off, ws_size); return; }

  static int grid_blocks = 0;
  if (!grid_blocks) {
    int dev = 0, cus = 0, per_cu = 0;
    (void)hipGetDevice(&dev);
    (void)hipDeviceGetAttribute(&cus, hipDeviceAttributeMultiprocessorCount, dev);
    (void)hipOccupancyMaxActiveBlocksPerMultiprocessor(&per_cu, mega, NTHREADS, 0);
    if (per_cu < 1) fprintf(stderr, "occupancy query says the kernel does not fit a CU\n");
    grid_blocks = cus & ~7;
  }
  (void)hipMemsetAsync(p.bar, 0, (size_t)XCD_BAR_WORDS * 4, stream);
  void* args[] = {&p};
  hipError_t e = hipLaunchCooperativeKernel((void*)mega, dim3(grid_blocks), dim3(NTHREADS), args, 0, stream);
  if (e != hipSuccess) fprintf(stderr, "cooperative launch failed: %s (grid %d)\n", hipGetErrorString(e), grid_blocks);
}
```

```cpp
#include <hip/hip_runtime.h>
#include <hip/hip_cooperative_groups.h>
#include <stdint.h>
#include <stdio.h>
namespace cg = cooperative_groups;

#ifndef DUP_PHASE
#define DUP_PHASE -1
#endif
#ifndef DUP_PARTS
#define DUP_PARTS 7
#endif
#ifndef PROBE_TYPE
#define PROBE_TYPE 0
#endif
#ifndef PP_OUT
#define PP_OUT 1
#endif
#ifndef PP_N2
#define PP_N2 1
#endif
#ifndef PP_PQ
#define PP_PQ 1
#endif

typedef unsigned short bf16_t;
typedef __attribute__((ext_vector_type(8))) short bf16x8;
typedef __attribute__((ext_vector_type(16))) float f32x16;
typedef __attribute__((ext_vector_type(4))) unsigned u32x4;
typedef __attribute__((ext_vector_type(2))) unsigned u32x2;
typedef __attribute__((ext_vector_type(4))) short s16x4;
#define DI __device__ __forceinline__
#define LDSP __attribute__((address_space(3)))

#define T_TOK 65536
#define SEQ 4096
#define NB 16
#define DM 1024
#define INW 2560
#define NGRP 40
#define MEMLEN 256
#define NTHREADS 512
#define WPB 8
#define STAGE_BYTES 49152
#define RING_BYTES (3 * STAGE_BYTES)
#define LDS_BYTES 163840

struct Params {
  const float *x, *mem, *g_mix, *w_in, *qg_dil, *kg_dil, *qg_moba, *kg_moba, *qg_mem, *kg_mem, *g_memtok, *w_mem_kv,
      *og_dil, *og_moba, *og_mem, *w_out, *g_ffn, *w_peer_q, *sub1, *sub2, *peer_u, *peer_v;
  float* out;
  unsigned* bar;
  bf16_t *HN;
  bf16_t *QKV;
  bf16_t *MEMN;
  bf16_t *KVM;
  bf16_t *WinT, *WoutT, *WqT, *WmkvT;
  bf16_t *SUB1, *SUB2;
  uint8_t *U8s, *V8s;
  float *SU, *SV;
  float *SW;
  uint8_t *X8;
  float *SX;
  float *PP;
  float *KMEAN;
  bf16_t *DILO;
  float *LSE2;
  unsigned short *PIDX;
  float *PGATE;
};

typedef const __attribute__((address_space(4))) Params* KernargPtr;
DI KernargPtr karg() {
#if defined(__HIP_DEVICE_COMPILE__)
  KernargPtr q = (KernargPtr)__builtin_amdgcn_kernarg_segment_ptr();
  asm volatile("" : "+s"(q));
  return q;
#else
  return nullptr;
#endif
}
DI float bf2f(bf16_t v) { return __uint_as_float(((unsigned)v) << 16); }
typedef __attribute__((ext_vector_type(2))) __bf16 bf16v2;
typedef __attribute__((ext_vector_type(2))) float f32x2;
DI unsigned pack2(float a, float b) { f32x2 v = {a, b}; return __builtin_bit_cast(unsigned, __builtin_convertvector(v, bf16v2)); }
template <int CTRL>
DI float dppf(float v) { return __int_as_float(__builtin_amdgcn_update_dpp(0, __float_as_int(v), CTRL, 0xf, 0xf, true)); }
DI float sum8(float v) { v += dppf<0xB1>(v); v += dppf<0x4E>(v); v += dppf<0x141>(v); return v; }
DI float sum16(float v) { v = sum8(v); v += dppf<0x140>(v); return v; }
DI float max16(float v) { v = fmaxf(v, dppf<0xB1>(v)); v = fmaxf(v, dppf<0x4E>(v)); v = fmaxf(v, dppf<0x141>(v)); v = fmaxf(v, dppf<0x140>(v)); return v; }
DI float sum32(float v) {
  v = sum16(v);
  auto rr = __builtin_amdgcn_permlane16_swap(__float_as_uint(v), __float_as_uint(v), false, false);
  return __uint_as_float(rr[0]) + __uint_as_float(rr[1]);
}
DI float max32(float v) {
  v = max16(v);
  auto rr = __builtin_amdgcn_permlane16_swap(__float_as_uint(v), __float_as_uint(v), false, false);
  return fmaxf(__uint_as_float(rr[0]), __uint_as_float(rr[1]));
}
DI float wave_sum(float v) {
  v = sum32(v);
  auto rr = __builtin_amdgcn_permlane32_swap(__float_as_uint(v), __float_as_uint(v), false, false);
  return __uint_as_float(rr[0]) + __uint_as_float(rr[1]);
}
DI float wave_max(float v) {
  v = max32(v);
  auto rr = __builtin_amdgcn_permlane32_swap(__float_as_uint(v), __float_as_uint(v), false, false);
  return fmaxf(__uint_as_float(rr[0]), __uint_as_float(rr[1]));
}
DI int crow(int i, int h) { return (i & 3) + 8 * (i >> 2) + 4 * h; }

DI void rmsnorm_rows(const int tid_, const float* __restrict__ src, const float* __restrict__ g, bf16_t* __restrict__ dst, int rows, int gw, int nw) {
  const int lane = tid_ & 63;
  for (int row = gw; row < rows; row += nw) {
    const float4* s4 = (const float4*)(src + (size_t)row * DM);
    float4 v[4];
    float ss = 0.f;
#pragma unroll
    for (int i = 0; i < 4; ++i) { v[i] = s4[lane + 64 * i]; ss += v[i].x * v[i].x + v[i].y * v[i].y + v[i].z * v[i].z + v[i].w * v[i].w; }
    ss = wave_sum(ss);
    const float rinv = rsqrtf(ss * (1.0f / DM) + 1e-6f);
#pragma unroll
    for (int i = 0; i < 4; ++i) {
      const float4 gg = ((const float4*)g)[lane + 64 * i];
      uint2 o;
      o.x = pack2(v[i].x * rinv * gg.x, v[i].y * rinv * gg.y);
      o.y = pack2(v[i].z * rinv * gg.z, v[i].w * rinv * gg.w);
      ((uint2*)(dst + (size_t)row * DM))[lane + 64 * i] = o;
    }
  }
}
DI void transpose_w(const float* __restrict__ W, bf16_t* __restrict__ Wt, int K, int N, int gt, int nt) {
  const int total = N * (K / 8);
  for (int idx = gt; idx < total; idx += nt) {
    const int n = idx % N, kc = idx / N;
    unsigned o[4];
#pragma unroll
    for (int j = 0; j < 4; ++j) o[j] = pack2(W[(size_t)(kc * 8 + 2 * j) * N + n], W[(size_t)(kc * 8 + 2 * j + 1) * N + n]);
    *(uint4*)(Wt + (size_t)n * K + kc * 8) = make_uint4(o[0], o[1], o[2], o[3]);
  }
}
DI void convert_u_int8(const int tid_, const float* __restrict__ src, uint8_t* __restrict__ dst, float* __restrict__ su, int gw, int nw) {
  const int lane = tid_ & 63;
  for (int e = gw; e < 16384; e += nw) {
    const float4* s4 = (const float4*)(src + (size_t)e * DM);
    float4 v[4];
    float mx = 0.f;
#pragma unroll
    for (int i = 0; i < 4; ++i) { v[i] = s4[lane + 64 * i]; mx = fmaxf(mx, fmaxf(fmaxf(fabsf(v[i].x), fabsf(v[i].y)), fmaxf(fabsf(v[i].z), fabsf(v[i].w)))); }
    mx = wave_max(mx);
    const float inv = mx > 0.f ? 127.0f / mx : 0.f;
    if (lane == 0) su[e] = mx * (1.0f / 127.0f);
#pragma unroll
    for (int i = 0; i < 4; ++i) {
      const unsigned q = ((unsigned)__float2int_rn(v[i].x * inv) & 0xffu) | (((unsigned)__float2int_rn(v[i].y * inv) & 0xffu) << 8) |
                         (((unsigned)__float2int_rn(v[i].z * inv) & 0xffu) << 16) | (((unsigned)__float2int_rn(v[i].w * inv) & 0xffu) << 24);
      const int slice = 2 * i + (lane >> 5);
      *(unsigned*)(dst + ((size_t)slice * 16384 + e) * 128 + 4 * (lane & 31)) = q;
    }
  }
}
DI void convert_subkeys(const float* __restrict__ src, bf16_t* __restrict__ dst, int gt, int nt_) {
  for (int i = gt; i < 8 * 128 * 16; i += nt_) {
    const int grp = i & 15, row = i >> 4;
    const int h = grp & 1, ns = grp >> 1;
    const float* sp = src + (size_t)row * 128 + 16 * ns + 4 * h;
    const float4 a = *(const float4*)sp, b = *(const float4*)(sp + 8);
    *(uint4*)(dst + (size_t)row * 128 + grp * 8) = make_uint4(pack2(a.x, a.y), pack2(a.z, a.w), pack2(b.x, b.y), pack2(b.z, b.w));
  }
}
DI void phase_prep(const int tid_, const Params& p, int bid, int nblk) {
  const int gt = bid * NTHREADS + tid_, nt = nblk * NTHREADS;
  const int gw = gt >> 6, nw = nt >> 6;
  rmsnorm_rows(tid_, p.x, p.g_mix, p.HN, T_TOK, gw, nw);
  rmsnorm_rows(tid_, p.mem, p.g_memtok, p.MEMN, NB * MEMLEN, gw, nw);
  transpose_w(p.w_in, p.WinT, DM, INW, gt, nt);
  transpose_w(p.w_out, p.WoutT, DM, DM, gt, nt);
  transpose_w(p.w_peer_q, p.WqT, DM, 2048, gt, nt);
  transpose_w(p.w_mem_kv, p.WmkvT, DM, 512, gt, nt);
  convert_subkeys(p.sub1, p.SUB1, gt, nt);
  convert_subkeys(p.sub2, p.SUB2, gt, nt);
  convert_u_int8(tid_, p.peer_u, p.U8s, p.SU, gw, nw);
  convert_u_int8(tid_, p.peer_v, p.V8s, p.SV, gw, nw);
}

DI void gemm_stage(const int tid_, const bf16_t* __restrict__ A, const bf16_t* __restrict__ Bt, int K, int m0, int n0, int k0, char* stg) {
  const int lane = tid_ & 63, wave = tid_ >> 6;
  const int lr = lane >> 3, spos = lane & 7;
#pragma unroll
  for (int j = 0; j < 4; ++j) {
    const int row = 32 * wave + 8 * j + lr;
    const int sw = (spos ^ ((row >> 1) & 7)) << 3;
    __builtin_amdgcn_global_load_lds((const unsigned*)(A + (size_t)(m0 + row) * K + k0 + sw),
                                     (LDSP unsigned*)(stg + (32 * wave + 8 * j) * 128 + lane * 16), 16, 0, 0);
  }
#pragma unroll
  for (int j = 0; j < 2; ++j) {
    const int row = 16 * wave + 8 * j + lr;
    const int sw = (spos ^ ((row >> 1) & 7)) << 3;
    __builtin_amdgcn_global_load_lds((const unsigned*)(Bt + (size_t)(n0 + row) * K + k0 + sw),
                                     (LDSP unsigned*)(stg + 32768 + (16 * wave + 8 * j) * 128 + lane * 16), 16, 0, 0);
  }
}
#define RING_WAIT(more_in_flight)                                                     \
  do {                                                                                \
    if (more_in_flight) asm volatile("s_waitcnt vmcnt(6) lgkmcnt(0)" ::: "memory");   \
    else asm volatile("s_waitcnt vmcnt(0) lgkmcnt(0)" ::: "memory");                  \
    __builtin_amdgcn_s_barrier();                                                     \
  } while (0)

#define BIG_STAGE_BYTES 65536
DI void dma16_saddr(const void* sbase, unsigned voff, unsigned lds_dst) {
  unsigned keep;
  asm volatile("s_mov_b32 %0, m0\n\ts_mov_b32 m0, %3\n\ts_nop 0\n\tglobal_load_lds_dwordx4 %1, %2\n\ts_mov_b32 m0, %0"
               : "=&s"(keep) : "v"(voff), "s"(sbase), "s"(lds_dst) : "memory");
}
DI void gemm_big(const int tid_, const bf16_t* __restrict__ A, const bf16_t* __restrict__ Bt, int K, int m0, int n0, char* lds, f32x16 (&acc)[4][2]) {
  const int tid = tid_, lane = tid & 63, wave = tid >> 6;
  const int wm = wave >> 2, wn = wave & 3, r = lane & 31, h = lane >> 5;
#pragma unroll
  for (int a = 0; a < 4; ++a)
#pragma unroll
    for (int b = 0; b < 2; ++b)
#pragma unroll
      for (int i = 0; i < 16; ++i) acc[a][b][i] = 0.f;
  const int nk = K >> 6;
  unsigned loff[4];
#pragma unroll
  for (int j = 0; j < 4; ++j) {
    const int row = 32 * wave + 8 * j + (lane >> 3);
    loff[j] = (unsigned)((row * K + (((lane & 7) ^ ((row >> 1) & 7)) << 3)) * 2);
  }
  const int wave_s = __builtin_amdgcn_readfirstlane(wave);
  const unsigned lds0 = (unsigned)(size_t)lds + (unsigned)(wave_s * 32 * 128);
  const char* Ab = (const char*)(A + (size_t)m0 * K);
  const char* Bb = (const char*)(Bt + (size_t)n0 * K);
  asm volatile("s_waitcnt vmcnt(0)" ::: "memory");
  __syncthreads();
#pragma unroll
  for (int j = 0; j < 4; ++j) { dma16_saddr(Ab, loff[j], lds0 + j * 1024); dma16_saddr(Bb, loff[j], lds0 + 32768 + j * 1024); }
  int aoff[4], boff[2];
  const int fsw = (r >> 1) & 7;
#pragma unroll
  for (int t = 0; t < 4; ++t) aoff[t] = (wm * 128 + t * 32 + r) * 128;
#pragma unroll
  for (int t = 0; t < 2; ++t) boff[t] = 32768 + (wn * 64 + t * 32 + r) * 128;
  for (int kt = 0; kt < nk; ++kt) {
    asm volatile("s_waitcnt vmcnt(0) lgkmcnt(0)" ::: "memory");
    __builtin_amdgcn_s_barrier();
    const char* Sc = lds + (kt & 1) * BIG_STAGE_BYTES;
    const unsigned ldn = lds0 + (unsigned)(((kt + 1) & 1) * BIG_STAGE_BYTES);
    const bool more = kt + 1 < nk;
    const char* An = Ab + (size_t)(kt + 1) * 128;
    const char* Bn = Bb + (size_t)(kt + 1) * 128;
    bf16x8 af[2][4], bfr[2][2];
    {
      const int co = (h ^ fsw) << 4;
#pragma unroll
      for (int t = 0; t < 4; ++t) af[0][t] = *(const bf16x8*)(Sc + aoff[t] + co);
#pragma unroll
      for (int t = 0; t < 2; ++t) bfr[0][t] = *(const bf16x8*)(Sc + boff[t] + co);
    }
#pragma unroll
    for (int s = 0; s < 4; ++s) {
      if (s < 3) {
        const int co = ((2 * (s + 1) + h) ^ fsw) << 4;
#pragma unroll
        for (int t = 0; t < 4; ++t) af[(s + 1) & 1][t] = *(const bf16x8*)(Sc + aoff[t] + co);
#pragma unroll
        for (int t = 0; t < 2; ++t) bfr[(s + 1) & 1][t] = *(const bf16x8*)(Sc + boff[t] + co);
      }
      if (more && s < 2) {
        dma16_saddr(An, loff[2 * s], ldn + (2 * s) * 1024); dma16_saddr(Bn, loff[2 * s], ldn + 32768 + (2 * s) * 1024);
        dma16_saddr(An, loff[2 * s + 1], ldn + (2 * s + 1) * 1024); dma16_saddr(Bn, loff[2 * s + 1], ldn + 32768 + (2 * s + 1) * 1024);
      }
      __builtin_amdgcn_sched_barrier(0);
      __builtin_amdgcn_s_setprio(1);
#pragma unroll
      for (int a = 0; a < 4; ++a)
#pragma unroll
        for (int b = 0; b < 2; ++b) acc[a][b] = __builtin_amdgcn_mfma_f32_32x32x16_bf16(af[s & 1][a], bfr[s & 1][b], acc[a][b], 0, 0, 0);
      __builtin_amdgcn_s_setprio(0);
      __builtin_amdgcn_sched_barrier(0);
    }
  }
}
DI void gemm_big_dump(const int tid_, const f32x16 (&acc)[4][2], int pass, char* lds) {
  const int lane = tid_ & 63, wave = tid_ >> 6;
  const int wm = wave >> 2, wn = wave & 3, r = lane & 31, h = lane >> 5;
  __syncthreads();
  if ((wn >> 1) == pass) {
    float* Cs = (float*)lds;
#pragma unroll
    for (int a = 0; a < 4; ++a)
#pragma unroll
      for (int b = 0; b < 2; ++b)
#pragma unroll
        for (int i = 0; i < 16; ++i) Cs[(wm * 128 + a * 32 + crow(i, h)) * 132 + (wn & 1) * 64 + b * 32 + r] = acc[a][b][i];
  }
  __syncthreads();
}

#define KM_TOTAL (NB * 6 * 16 * 64)
#define X1B(p) ((p).QKV + (size_t)8 * T_TOK * 128)
DI void epi_headnorm(const int tid_, const float* Cs, bf16_t* __restrict__ dst, size_t rows_total, int m0, int g0, const float* gain0, const float* gain1,
                     bf16_t* kmean = nullptr, float* red = nullptr, float qscale = 1.0f) {
  const int tid = tid_;
  float csum[8] = {0.f, 0.f, 0.f, 0.f, 0.f, 0.f, 0.f, 0.f};
#pragma unroll 1
  for (int it = 0; it < 8; ++it) {
    const int task = tid + NTHREADS * it;
    const int sub = task & 7, grp = (task >> 3) & 1, row = task >> 4;
    const float4 c0 = *(const float4*)(Cs + row * 132 + grp * 64 + sub * 8);
    const float4 c1 = *(const float4*)(Cs + row * 132 + grp * 64 + sub * 8 + 4);
    float v[8] = {c0.x, c0.y, c0.z, c0.w, c1.x, c1.y, c1.z, c1.w};
    const float* gain = grp ? gain1 : gain0;
    float ss = 0.f;
#pragma unroll
    for (int j = 0; j < 8; ++j) ss += v[j] * v[j];
    ss = sum8(ss);
    if (gain) {
      const float rinv = rsqrtf(ss * (1.0f / 64.0f) + 1e-6f) * qscale;
#pragma unroll
      for (int j = 0; j < 8; ++j) v[j] *= rinv * gain[sub * 8 + j];
    }
    *(uint4*)(dst + ((size_t)(g0 + grp) * rows_total + m0 + row) * 64 + sub * 8) =
        make_uint4(pack2(v[0], v[1]), pack2(v[2], v[3]), pack2(v[4], v[5]), pack2(v[6], v[7]));
    if (kmean) {
#pragma unroll
      for (int j = 0; j < 8; ++j) csum[j] += v[j];
    }
  }
  if (kmean) {
#pragma unroll
    for (int j = 0; j < 8; ++j) red[(tid >> 4) * 128 + (tid & 15) * 8 + j] = csum[j];
    __syncthreads();
    if (tid < 128) {
      float a = 0.f;
#pragma unroll 8
      for (int rgrp = 0; rgrp < 32; ++rgrp) a += red[rgrp * 128 + tid];
      const float av = a * (1.0f / 256.0f);
      const unsigned ph = pack2(av, 0.f) & 0xffffu;
      const unsigned pl = pack2(av - __uint_as_float(ph << 16), 0.f) & 0xffffu;
      kmean[(tid >> 6) * 1024 + (tid & 63)] = (bf16_t)ph;
      kmean[KM_TOTAL + (tid >> 6) * 1024 + (tid & 63)] = (bf16_t)pl;
    }
  }
}
DI const float* gain_for_group(const Params& p, int g) {
  const int kind = g / 6;
  switch (kind) {
    case 0: return p.qg_dil;
    case 1: return p.kg_dil;
    case 3: return p.qg_moba;
    case 4: return p.kg_moba;
    case 6: return p.qg_mem;
    default: return nullptr;
  }
}

DI bool xcd_tile_big(int bid, int nblk, int it, int n_tiles_n, int& mt, int& nt) {
  const int x = bid & 7, j = bid >> 3, nb = nblk >> 3;
  const int seq = it * nb + j;
  if (seq >= 32 * n_tiles_n) return false;
  const int per_group = 4 * n_tiles_n;
  const int mg = seq / per_group, rem = seq - mg * per_group;
  nt = rem >> 2; mt = x * 32 + mg * 4 + (rem & 3);
  return true;
}

DI void phase_proj(const int tid_, const Params& p, int bid, int nblk, char* lds) {
  int mt, nt;
  f32x16 acc[4][2];
  for (int it = 0; xcd_tile_big(bid, nblk, it, 10, mt, nt); ++it) {
    gemm_big(tid_, p.HN, p.WinT, DM, mt * 256, nt * 256, lds, acc);
#pragma unroll 1
    for (int pass = 0; pass < 2; ++pass) {
      gemm_big_dump(tid_, acc, pass, lds);
      const int g0 = nt * 4 + pass * 2;
      bf16_t* km = (g0 >= 24 && g0 < 30) ? (bf16_t*)p.KMEAN + ((size_t)((mt >> 4) * 6 + (g0 - 24)) * 16 + (mt & 15)) * 64 : nullptr;
      epi_headnorm(tid_, (const float*)lds, p.QKV, T_TOK, mt * 256, g0, gain_for_group(p, g0), gain_for_group(p, g0 + 1), km, (float*)(lds + RING_BYTES),
                   (g0 < 6 || (g0 >= 18 && g0 < 24) || g0 >= 36) ? 0.125f * 1.4426950408889634f : 1.0f);
    }
  }
  for (int t2 = bid; t2 < 16 * 2; t2 += nblk) {
    const int mt2 = t2 >> 1, nt2 = t2 & 1;
    gemm_big(tid_, p.MEMN, p.WmkvT, DM, mt2 * 256, nt2 * 256, lds, acc);
#pragma unroll 1
    for (int pass = 0; pass < 2; ++pass) {
      gemm_big_dump(tid_, acc, pass, lds);
      const float* gn = (nt2 == 0) ? p.kg_mem : nullptr;
      epi_headnorm(tid_, (const float*)lds, p.KVM, NB * MEMLEN, mt2 * 256, nt2 * 4 + pass * 2, gn, gn);
    }
  }
}

DI float alibi_slope(int i) { return exp2f(-8.0f * (float)(i + 1) / 12.0f); }

#define LOG2E 1.4426950408889634f
#define ATT_SCALE2 (0.125f * LOG2E)
#define MASKVAL (-3.0e38f)

struct AttnState { float m, l; f32x16 o[2]; };

template <bool BIAS>
DI void attn_tile64(const int tid_, const char* Kl, const char* Vl, const bf16x8 (&qf)[4], AttnState& st, float A, const float (&Bc)[2][16],
                    float dqh, int mode0, int mode1, bool colvalid, float lo, float hi) {
  const int lane = tid_ & 63, r = lane & 31, h = lane >> 5;
  f32x16 s0, s1;
#pragma unroll
  for (int i = 0; i < 16; ++i) { s0[i] = 0.f; s1[i] = 0.f; }
  const char* kp = Kl + r * 128;
  const int ksw = (r >> 1) & 7;
#pragma unroll
  for (int ks = 0; ks < 4; ++ks) {
    const bf16x8 k0 = *(const bf16x8*)(kp + (((2 * ks + h) ^ ksw) << 4));
    const bf16x8 k1 = *(const bf16x8*)(kp + 4096 + (((2 * ks + h) ^ ksw) << 4));
    s0 = __builtin_amdgcn_mfma_f32_32x32x16_bf16(k0, qf[ks], s0, 0, 0, 0);
    s1 = __builtin_amdgcn_mfma_f32_32x32x16_bf16(k1, qf[ks], s1, 0, 0, 0);
  }
  const f32x2 sc2 = {ATT_SCALE2, ATT_SCALE2};
#pragma unroll
  for (int j = 0; j < 8; ++j) {
    f32x2 a0 = {s0[2 * j], s0[2 * j + 1]}, a1 = {s1[2 * j], s1[2 * j + 1]};
    if (BIAS) {
      const f32x2 b0 = {Bc[0][2 * j], Bc[0][2 * j + 1]}, b1 = {Bc[1][2 * j], Bc[1][2 * j + 1]};
      a0 = __builtin_elementwise_fma(a0, sc2, b0); a1 = __builtin_elementwise_fma(a1, sc2, b1);
    } else { a0 = a0 * sc2; a1 = a1 * sc2; }
    s0[2 * j] = a0[0]; s0[2 * j + 1] = a0[1]; s1[2 * j] = a1[0]; s1[2 * j + 1] = a1[1];
  }
  if (BIAS && mode0 != 1) {
#pragma unroll
    for (int i = 0; i < 16; ++i) {
      const float delta = dqh - (float)((i & 3) + 8 * (i >> 2));
      s0[i] = (mode0 == 2 && delta >= lo && delta <= hi) ? s0[i] : MASKVAL;
    }
  }
  if (BIAS && mode1 != 1) {
#pragma unroll
    for (int i = 0; i < 16; ++i) {
      const float delta = dqh - (float)(32 + (i & 3) + 8 * (i >> 2));
      s1[i] = (mode1 == 2 && delta >= lo && delta <= hi) ? s1[i] : MASKVAL;
    }
  }
  float tmax = __builtin_fmaxf(s0[0], s1[0]);
#pragma unroll
  for (int i = 1; i < 16; ++i) tmax = __builtin_fmaxf(__builtin_fmaxf(tmax, s0[i]), s1[i]);
  tmax += A;
  tmax = colvalid ? tmax : MASKVAL;
  tmax = fmaxf(tmax, __shfl_xor(tmax, 32));
  const float mnew = fmaxf(st.m, tmax);
  const float alpha = __builtin_amdgcn_exp2f(st.m - mnew);
  st.m = mnew;
  const float dsub = colvalid ? mnew - A : 3.0e38f;
  const f32x2 nd2 = {-dsub, -dsub};
  f32x2 ps0 = {0.f, 0.f}, ps1 = {0.f, 0.f};
#pragma unroll
  for (int j = 0; j < 8; ++j) {
    f32x2 a0 = {s0[2 * j], s0[2 * j + 1]}, a1 = {s1[2 * j], s1[2 * j + 1]};
    a0 = a0 + nd2; a1 = a1 + nd2;
    a0[0] = __builtin_amdgcn_exp2f(a0[0]); a0[1] = __builtin_amdgcn_exp2f(a0[1]);
    a1[0] = __builtin_amdgcn_exp2f(a1[0]); a1[1] = __builtin_amdgcn_exp2f(a1[1]);
    ps0 = ps0 + a0; ps1 = ps1 + a1;
    s0[2 * j] = a0[0]; s0[2 * j + 1] = a0[1]; s1[2 * j] = a1[0]; s1[2 * j + 1] = a1[1];
  }
  ps0 = ps0 + ps1;
  st.l = st.l * alpha + (ps0[0] + ps0[1]);
  if (__ballot(alpha != 1.0f) != 0ull) {
#pragma unroll
    for (int i = 0; i < 16; ++i) { st.o[0][i] *= alpha; st.o[1][i] *= alpha; }
  }
  const int q4 = (lane & 15) >> 2, p4 = lane & 3, g = (lane >> 4) & 1;
#pragma unroll
  for (int s2 = 0; s2 < 4; ++s2) {
    u32x4 pk;
    if (s2 < 2) {
      pk[0] = pack2(s0[8 * s2 + 0], s0[8 * s2 + 1]); pk[1] = pack2(s0[8 * s2 + 2], s0[8 * s2 + 3]);
      pk[2] = pack2(s0[8 * s2 + 4], s0[8 * s2 + 5]); pk[3] = pack2(s0[8 * s2 + 6], s0[8 * s2 + 7]);
    } else {
      pk[0] = pack2(s1[8 * (s2 - 2) + 0], s1[8 * (s2 - 2) + 1]); pk[1] = pack2(s1[8 * (s2 - 2) + 2], s1[8 * (s2 - 2) + 3]);
      pk[2] = pack2(s1[8 * (s2 - 2) + 4], s1[8 * (s2 - 2) + 5]); pk[3] = pack2(s1[8 * (s2 - 2) + 6], s1[8 * (s2 - 2) + 7]);
    }
    const bf16x8 pf = __builtin_bit_cast(bf16x8, pk);
    const int row_lo = 16 * s2 + 4 * h + q4;
    const int row_hi = row_lo + 8;
    const int sw_lo = ((row_lo >> 1) & 1) << 6, sw_hi = ((row_hi >> 1) & 1) << 6;
#pragma unroll
    for (int dt = 0; dt < 2; ++dt) {
      const int cb = 64 * dt + 32 * g + 8 * p4;
      const s16x4 lo4 = __builtin_amdgcn_ds_read_tr16_b64_v4i16((LDSP s16x4*)(Vl + row_lo * 128 + (cb ^ sw_lo)));
      const s16x4 hi4 = __builtin_amdgcn_ds_read_tr16_b64_v4i16((LDSP s16x4*)(Vl + row_hi * 128 + (cb ^ sw_hi)));
      const bf16x8 vf = __builtin_shufflevector(lo4, hi4, 0, 1, 2, 3, 4, 5, 6, 7);
      st.o[dt] = __builtin_amdgcn_mfma_f32_32x32x16_bf16(vf, pf, st.o[dt], 0, 0, 0);
    }
  }
}

#define ATT_STAGE_BYTES 16384
#define ATT_NSTAGE 8
#define ATT_LA 6
DI void attn_tile_dma(const int tid_, const bf16_t*& kp, const bf16_t*& vp, long tstride, char* stg) {
  const int lane = tid_ & 63, w8 = tid_ >> 6;
  __builtin_amdgcn_global_load_lds((const unsigned*)kp, (LDSP unsigned*)(stg + w8 * 1024 + lane * 16), 16, 0, 0);
  __builtin_amdgcn_global_load_lds((const unsigned*)vp, (LDSP unsigned*)(stg + 8192 + w8 * 1024 + lane * 16), 16, 0, 0);
  kp += tstride; vp += tstride;
}

template <int TYPE>
DI void attn_item(const int tid_, const Params& p, char* lds, int b, int hd, int m, int c, int res) {
  const int tid = tid_, lane = tid & 63, w8 = tid >> 6, nh = w8 >> 2, w = w8 & 3, r = lane & 31, h = lane >> 5;
  const int n = 2 * m + nh;
  const size_t tb = (size_t)b * SEQ;
  const bf16_t *Q, *Kb, *Vb;
  int d = 1;
  float slope2 = 0.f;
  if (TYPE == 0) {
    Q = p.QKV + ((size_t)(36 + hd) * T_TOK + tb) * 64;
    Kb = p.KVM + ((size_t)hd * (NB * MEMLEN) + (size_t)b * MEMLEN) * 64;
    Vb = p.KVM + ((size_t)(4 + hd) * (NB * MEMLEN) + (size_t)b * MEMLEN) * 64;
  } else if (TYPE == 1) {
    Q = p.QKV + ((size_t)hd * T_TOK + tb) * 64;
    Kb = p.QKV + ((size_t)(6 + hd) * T_TOK + tb) * 64;
    Vb = p.QKV + ((size_t)(12 + hd) * T_TOK + tb) * 64;
    d = (c == 0) ? 1 : (c == 1 ? 4 : 16);
    slope2 = alibi_slope(2 * hd) * (float)d * LOG2E;
  } else {
    Q = p.QKV + ((size_t)(18 + hd) * T_TOK + tb) * 64;
    Kb = p.QKV + ((size_t)(24 + hd) * T_TOK + tb) * 64;
    Vb = p.QKV + ((size_t)(30 + hd) * T_TOK + tb) * 64;
    slope2 = alibi_slope(2 * hd + 1) * LOG2E;
  }
  int t_lo, t_hi;
  long krow0, kstride;
  if (TYPE == 0) { t_lo = 0; t_hi = 4; krow0 = 0; kstride = 1; }
  else if (TYPE == 1) { t_lo = (m == 0) ? 2 : 0; t_hi = 6; krow0 = (long)(128 * (2 * m - 1)) * d + res; kstride = d; }
  else { t_lo = 0; t_hi = 4 * m + 4; krow0 = 0; kstride = 1; }

  const bf16_t* kp;
  const bf16_t* vp;
  {
    const int row = 8 * w8 + (lane >> 3), pos = lane & 7;
    const long grow = krow0 + ((long)t_lo * 64 + row) * kstride;
    kp = Kb + grow * 64 + ((pos ^ ((row >> 1) & 7)) << 3);
    vp = Vb + grow * 64 + ((pos ^ (((row >> 1) & 1) << 2)) << 3);
  }
  const long tstride = 64 * kstride * 64;
  {
    const int npro = (t_hi - t_lo) < ATT_LA ? (t_hi - t_lo) : ATT_LA;
    for (int i = 0; i < npro; ++i) attn_tile_dma(tid_, kp, vp, tstride, lds + i * ATT_STAGE_BYTES);
  }
  const int qsub = 128 * n + 32 * w + r;
  const long qrow = (TYPE == 1) ? ((long)qsub * d + res) : (long)qsub;
  bf16x8 qf[4];
#pragma unroll
  for (int ks = 0; ks < 4; ++ks) qf[ks] = *(const bf16x8*)(Q + qrow * 64 + (2 * ks + h) * 8);

  unsigned selmask = 0;
  const int own = n >> 1;
  if (TYPE == 2 && own > 0) {
    float qv[32];
#pragma unroll
    for (int ks = 0; ks < 4; ++ks)
#pragma unroll
      for (int j = 0; j < 8; ++j) qv[ks * 8 + j] = bf2f((bf16_t)qf[ks][j]);
    const float* km = p.KMEAN + (size_t)(b * 6 + hd) * 16 * 64;
    float v0 = -3.4e38f, v1 = -3.4e38f, v2 = -3.4e38f;
    int i0 = 31, i1 = 31, i2 = 31;
    for (int j = 0; j < own; ++j) {
      float part = 0.f;
#pragma unroll
      for (int ks = 0; ks < 4; ++ks) {
        const float4 k0 = *(const float4*)(km + j * 64 + 16 * ks + 8 * h);
        const float4 k1 = *(const float4*)(km + j * 64 + 16 * ks + 8 * h + 4);
        part += qv[ks * 8 + 0] * k0.x + qv[ks * 8 + 1] * k0.y + qv[ks * 8 + 2] * k0.z + qv[ks * 8 + 3] * k0.w +
                qv[ks * 8 + 4] * k1.x + qv[ks * 8 + 5] * k1.y + qv[ks * 8 + 6] * k1.z + qv[ks * 8 + 7] * k1.w;
      }
      const float gte = part + __shfl_xor(part, 32);
      if (gte > v2) {
        if (gte > v1) {
          v2 = v1; i2 = i1;
          if (gte > v0) { v1 = v0; i1 = i0; v0 = gte; i0 = j; } else { v1 = gte; i1 = j; }
        } else { v2 = gte; i2 = j; }
      }
    }
    selmask = ((1u << i0) | (1u << i1) | (1u << i2)) & 0xffffu;
  }

  AttnState st;
  st.m = -1.0e30f; st.l = 0.f;
#pragma unroll
  for (int i = 0; i < 16; ++i) { st.o[0][i] = 0.f; st.o[1][i] = 0.f; }

  float Bc[2][16];
#pragma unroll
  for (int i = 0; i < 16; ++i) { Bc[0][i] = slope2 * (float)((i & 3) + 8 * (i >> 2)); Bc[1][i] = slope2 * (float)(32 + (i & 3) + 8 * (i >> 2)); }
  for (int t = t_lo; t < t_hi; ++t) {
    int ahead = t_hi - 1 - t;
    ahead = ahead > ATT_LA - 1 ? ATT_LA - 1 : ahead;
    switch (ahead) {
      case 5: asm volatile("s_waitcnt vmcnt(10) lgkmcnt(0)" ::: "memory"); break;
      case 4: asm volatile("s_waitcnt vmcnt(8) lgkmcnt(0)" ::: "memory"); break;
      case 3: asm volatile("s_waitcnt vmcnt(6) lgkmcnt(0)" ::: "memory"); break;
      case 2: asm volatile("s_waitcnt vmcnt(4) lgkmcnt(0)" ::: "memory"); break;
      case 1: asm volatile("s_waitcnt vmcnt(2) lgkmcnt(0)" ::: "memory"); break;
      default: asm volatile("s_waitcnt vmcnt(0) lgkmcnt(0)" ::: "memory"); break;
    }
    __builtin_amdgcn_s_barrier();
    if (t + ATT_LA < t_hi) attn_tile_dma(tid_, kp, vp, tstride, lds + ((t + ATT_LA - t_lo) & (ATT_NSTAGE - 1)) * ATT_STAGE_BYTES);
    const char* buf = lds + ((t - t_lo) & (ATT_NSTAGE - 1)) * ATT_STAGE_BYTES;
    int mode0 = 1, mode1 = 1;
    bool cv = true;
    float dq = 0.f, lo = 0.f, hi = 0.f;
    if (TYPE == 1) {
      const int ur0 = 2 * t - 4 * nh, ur1 = ur0 + 1;
      mode0 = (ur0 < w || ur0 > w + 4) ? 0 : ((ur0 == w || ur0 == w + 4) ? 2 : 1);
      mode1 = (ur1 < w || ur1 > w + 4) ? 0 : ((ur1 == w || ur1 == w + 4) ? 2 : 1);
      lo = 0.f; hi = 128.f;
      dq = (float)(qsub - (128 * (2 * m - 1) + 64 * t));
    } else if (TYPE == 2) {
      dq = (float)(qsub - 64 * t);
      if (t < 4 * m) { cv = (selmask >> (t >> 2)) & 1u; }
      else {
        const int uq = 4 * n + w;
        mode0 = (2 * t > uq) ? 0 : ((2 * t == uq) ? 2 : 1);
        mode1 = (2 * t + 1 > uq) ? 0 : ((2 * t + 1 == uq) ? 2 : 1);
        lo = 0.f; hi = 1.0e30f;
      }
    }
    if (mode0 == 0 && mode1 == 0) continue;
    const float dqh = dq - (float)(4 * h);
    attn_tile64<(TYPE != 0)>(tid_, buf, buf + 8192, qf, st, -slope2 * dqh, Bc, dqh, mode0, mode1, cv, lo, hi);
  }
  __syncthreads();

  const float ltot = st.l + __shfl_xor(st.l, 32);
  const float inv = 1.0f / ltot;
  bf16_t* dst;
  if (TYPE == 0) dst = p.HN + (tb + qsub) * DM + 768 + hd * 64;
  else if (TYPE == 2) dst = p.HN + (tb + qsub) * DM + 384 + hd * 64;
  else {
    const size_t tok = tb + (size_t)qrow;
    dst = p.DILO + ((size_t)c * T_TOK + tok) * 384 + hd * 64;
    if (h == 0) p.LSE2[((size_t)c * T_TOK + tok) * 6 + hd] = st.m + __builtin_amdgcn_logf(ltot);
  }
#pragma unroll
  for (int dt = 0; dt < 2; ++dt)
#pragma unroll
    for (int gq = 0; gq < 4; ++gq) {
      uint2 o;
      o.x = pack2(st.o[dt][4 * gq + 0] * inv, st.o[dt][4 * gq + 1] * inv);
      o.y = pack2(st.o[dt][4 * gq + 2] * inv, st.o[dt][4 * gq + 3] * inv);
      *(uint2*)(dst + 32 * dt + 8 * gq + 4 * h) = o;
    }
}

#define AH_SLOTB 8192
#define AH_LDS_K 0
#define AH_LDS_V (3 * AH_SLOTB)
#define AH_THR 8.0f
#define AH_SBAR() __builtin_amdgcn_sched_barrier(0)
#define AH_PIN(x) asm volatile("" : "+v"(x))
#define AH_MFMA(a, b, c) __builtin_amdgcn_mfma_f32_32x32x16_bf16(a, b, c, 0, 0, 0)
#define AH_WAIT_BAR(N) asm volatile("s_waitcnt vmcnt(" #N ") lgkmcnt(0)\n\ts_barrier" ::: "memory")
typedef __attribute__((address_space(3))) const char* ah_lds_cptr;
DI void ah_kload2(bf16x8* kf, ah_lds_cptr kp, int d0) {
  kf[2 * d0] = *(const __attribute__((address_space(3))) bf16x8*)(kp + d0 * 2048);
  kf[2 * d0 + 1] = *(const __attribute__((address_space(3))) bf16x8*)(kp + d0 * 2048 + 512);
}
DI s16x4 ah_vtr(ah_lds_cptr p) { return __builtin_amdgcn_ds_read_tr16_b64_v4i16((__attribute__((address_space(3))) s16x4*)p); }
#define AH_MX3(a, b, c) __builtin_fmaxf(__builtin_fmaxf((a), (b)), (c))
DI float ah_rowmax(const f32x16& p0, const f32x16& p1) {
  float a = AH_MX3(p0[0], p0[1], p1[0]), b = AH_MX3(p0[2], p0[3], p1[1]); a = AH_MX3(a, p1[2], p1[3]);
#pragma unroll
  for (int r = 4; r < 16; r += 4) { a = AH_MX3(a, p0[r], p0[r + 1]); b = AH_MX3(b, p0[r + 2], p0[r + 3]); a = AH_MX3(a, p1[r], p1[r + 1]); b = AH_MX3(b, p1[r + 2], p1[r + 3]); }
  const float m = __builtin_fmaxf(a, b);
  auto rr = __builtin_amdgcn_permlane32_swap(__float_as_uint(m), __float_as_uint(m), false, false);
  return __builtin_fmaxf(__uint_as_float(rr[0]), __uint_as_float(rr[1]));
}
DI void ah_cmask(f32x16& p0, f32x16& p1, int jb, int qrel, int hi) {
  const int kb = 64 * jb + 4 * hi;
#pragma unroll
  for (int r = 0; r < 16; ++r) { const int kv = kb + (r & 3) + 8 * (r >> 2); if (kv > qrel) p0[r] = -INFINITY; if (kv + 32 > qrel) p1[r] = -INFINITY; }
}

template <int TYPE>
DI void attn_unit_hi(const int tid_, const Params& p, char* lds, int b, int hd, int m) {
  const int tid = tid_, lane = tid & 63, r32 = lane & 31, hi = lane >> 5;
  const int wid = __builtin_amdgcn_readfirstlane(tid >> 6);
  const size_t tb = (size_t)b * SEQ;
  const bf16_t *Q, *Kb, *Vb;
  float slope2 = 0.f;
  if (TYPE == 0) {
    Q = p.QKV + ((size_t)(36 + hd) * T_TOK + tb) * 64;
    Kb = p.KVM + ((size_t)hd * (NB * MEMLEN) + (size_t)b * MEMLEN) * 64;
    Vb = p.KVM + ((size_t)(4 + hd) * (NB * MEMLEN) + (size_t)b * MEMLEN) * 64;
  } else {
    Q = p.QKV + ((size_t)(18 + hd) * T_TOK + tb) * 64;
    Kb = p.QKV + ((size_t)(24 + hd) * T_TOK + tb) * 64;
    Vb = p.QKV + ((size_t)(30 + hd) * T_TOK + tb) * 64;
    slope2 = alibi_slope(2 * hd + 1) * LOG2E;
  }
  const int q0 = 256 * m, NT = (TYPE == 0) ? 4 : 4 * m + 4;
  const bf16_t* Qw = Q + (size_t)(q0 + wid * 32) * 64;
  const unsigned lds0 = (unsigned)(size_t)lds;
  const unsigned koff = (unsigned)((lane * 64 + wid * 8) * 2);
  const unsigned voff = (unsigned)(((16 * (wid & 3) + (lane >> 2)) * 64 + (wid >> 2) * 32 + (lane & 3) * 8) * 2);
  const unsigned kdst = lds0 + AH_LDS_K + wid * 1024, vdst = lds0 + AH_LDS_V + wid * 1024;
  const char* Kc = (const char*)Kb;
  const char* Vc = (const char*)Vb;
#define AH_TA(u) ((TYPE == 2) ? (NT - 1 - (u)) : (u))
#define AH_DMA_K(t, slot) dma16_saddr(Kc + (size_t)AH_TA(t) * 8192, koff, kdst + (unsigned)(slot))
#define AH_DMA_V(t, slot) dma16_saddr(Vc + (size_t)AH_TA(t) * 8192, voff, vdst + (unsigned)(slot))
  const ah_lds_cptr vp0 = (ah_lds_cptr)lds + AH_LDS_V + ((lane >> 4) & 1) * 32 + (lane & 3) * 8 + (4 * hi + ((lane & 15) >> 2)) * 64;
  const ah_lds_cptr kp0 = (ah_lds_cptr)lds + AH_LDS_K + hi * 1024 + r32 * 16;
  AH_DMA_K(0, 0); AH_DMA_V(0, 0); AH_DMA_K(1, AH_SLOTB);
  bf16x8 qr[4];
#pragma unroll
  for (int d0 = 0; d0 < 4; ++d0) qr[d0] = *(const bf16x8*)(Qw + (size_t)r32 * 64 + d0 * 16 + hi * 8);
  unsigned selmask = 0;
  if (TYPE == 2 && m > 0) {
    const bf16_t* kmh = (const bf16_t*)p.KMEAN + (size_t)(b * 6 + hd) * 16 * 64 + (r32 & 15) * 64 + 8 * hi;
    bf16x8 ah[4], al[4];
#pragma unroll
    for (int ks = 0; ks < 4; ++ks) { ah[ks] = *(const bf16x8*)(kmh + 16 * ks); al[ks] = *(const bf16x8*)(kmh + KM_TOTAL + 16 * ks); }
    f32x16 g;
#pragma unroll
    for (int i = 0; i < 16; ++i) g[i] = 0.f;
#pragma unroll
    for (int ks = 0; ks < 4; ++ks) { g = AH_MFMA(ah[ks], qr[ks], g); g = AH_MFMA(al[ks], qr[ks], g); }
    float gv[16];
#pragma unroll
    for (int i = 0; i < 8; ++i) {
      auto rr = __builtin_amdgcn_permlane32_swap(__float_as_uint(g[i]), __float_as_uint(g[i]), false, false);
      gv[(i & 3) + 8 * (i >> 2)] = __uint_as_float(rr[0]);
      gv[(i & 3) + 8 * (i >> 2) + 4] = __uint_as_float(rr[1]);
    }
    float v0 = -3.4e38f, v1 = -3.4e38f, v2 = -3.4e38f;
    int i0 = 31, i1 = 31, i2 = 31;
#pragma unroll
    for (int j = 0; j < 16; ++j) {
      const float gte = gv[j];
      if (j < m && gte > v2) {
        if (gte > v1) {
          v2 = v1; i2 = i1;
          if (gte > v0) { v1 = v0; i1 = i0; v0 = gte; i0 = j; } else { v1 = gte; i1 = j; }
        } else { v2 = gte; i2 = j; }
      }
    }
    selmask = ((1u << i0) | (1u << i1) | (1u << i2)) & 0xffffu;
  }
  float mhat = 0.f, l_reg = 0.f, fres = 1.f;
  f32x16 o[2];
#pragma unroll
  for (int i = 0; i < 16; ++i) { o[0][i] = 0.f; o[1][i] = 0.f; }
  f32x16 zero16;
#pragma unroll
  for (int i = 0; i < 16; ++i) zero16[i] = 0.f;
  if (TYPE == 0) AH_PIN(zero16);
  const int qrel = wid * 32 + r32;
  const float qposh = (float)(q0 + qrel - 4 * hi);
  bool resc = false;
  f32x16 pA0, pA1, pB0, pB1;
  bf16x8 kf[8];
  s16x4 vlo[8], vhi[8];
  u32x4 pw0, pw1, pw2, pw3;
  int sl_prev = 0, sl_cur = 0, sl_next = AH_SLOTB;
#define AH_ROT() do { sl_prev = sl_cur; sl_cur = sl_next; sl_next = (sl_next == 2 * AH_SLOTB) ? 0 : sl_next + AH_SLOTB; } while (0)
#define AH_INIT(C0, C1, u, ref)                                                                                     \
  do {                                                                                                              \
    if (TYPE == 2) {                                                                                                \
      const int ta_ = AH_TA(u);                                                                                     \
      const bool cv_ = (ta_ >= 4 * m) || ((selmask >> (ta_ >> 2)) & 1u);                                            \
      const float s_ = cv_ ? (-slope2 * (qposh - (float)(64 * ta_)) - (ref)) : -1.0e30f;                            \
      _Pragma("unroll") for (int i_ = 0; i_ < 16; ++i_) {                                                           \
        C0[i_] = __builtin_fmaf(slope2, (float)((i_ & 3) + 8 * (i_ >> 2)), s_);                                     \
        C1[i_] = __builtin_fmaf(slope2, (float)(32 + (i_ & 3) + 8 * (i_ >> 2)), s_);                                \
      }                                                                                                             \
    }                                                                                                               \
  } while (0)
#define AH_CIN(C) ((TYPE == 2) ? (C) : zero16)
#define AH_EX(v) ((TYPE == 2) ? __builtin_amdgcn_exp2f(v) : __builtin_amdgcn_exp2f((v) + nmh))
#define AH_RESC() do { if (resc) { _Pragma("unroll") for (int r_ = 0; r_ < 16; ++r_) { o[0][r_] *= fres; o[1][r_] *= fres; } } } while (0)
  AH_DMA_K(2, 2 * AH_SLOTB);
  AH_WAIT_BAR(3);
#pragma unroll
  for (int d0 = 0; d0 < 4; ++d0) ah_kload2(kf, kp0, d0);
  AH_INIT(pA0, pA1, 0, 0.f);
  pA0 = AH_MFMA(kf[0], qr[0], AH_CIN(pA0)); pA1 = AH_MFMA(kf[1], qr[0], AH_CIN(pA1)); pA0 = AH_MFMA(kf[2], qr[1], pA0); pA1 = AH_MFMA(kf[3], qr[1], pA1);
  pA0 = AH_MFMA(kf[4], qr[2], pA0); pA1 = AH_MFMA(kf[5], qr[2], pA1); pA0 = AH_MFMA(kf[6], qr[3], pA0); pA1 = AH_MFMA(kf[7], qr[3], pA1);
  if (TYPE == 2) ah_cmask(pA0, pA1, 3, qrel, hi);
  {
    const float rm = ah_rowmax(pA0, pA1);
    mhat = (TYPE == 2) ? __builtin_fmaxf(rm, -1000.0f) : rm;
    const float nm0 = -mhat;
#pragma unroll
    for (int r = 0; r < 16; ++r) { pA0[r] = __builtin_amdgcn_exp2f(pA0[r] + nm0); pA1[r] = __builtin_amdgcn_exp2f(pA1[r] + nm0); }
  }
  AH_WAIT_BAR(0);
  AH_DMA_K(3, 0); AH_DMA_V(1, AH_SLOTB); AH_ROT();
#pragma unroll
  for (int d0 = 0; d0 < 4; ++d0) ah_kload2(kf, kp0 + sl_cur, d0);
  AH_WAIT_BAR(2);
#define AH_PKW(P, i) pack2(P[i], P[i + 1])
#define AH_PAF(k) __builtin_bit_cast(bf16x8, pw##k)
#define AH_VFR(i) (bf16x8){vlo[i][0], vlo[i][1], vlo[i][2], vlo[i][3], vhi[i][0], vhi[i][1], vhi[i][2], vhi[i][3]}
#define AH_VRD(i) do { vlo[i] = ah_vtr(vp_ + (((i) >> 2) * 4096 + ((i) & 3) * 1024)); vhi[i] = ah_vtr(vp_ + (((i) >> 2) * 4096 + ((i) & 3) * 1024 + 512)); } while (0)
#define AH_KRD(G, d0) do { if (G) { ah_kload2(kf, kp0 + sl_next, d0); AH_SBAR(); } } while (0)
#define AH_GAPA(MF, a0, a1, a2, a3, W0, W1, PW) do { MF; sacc += a0; sacc += a1; sacc += a2; sacc += a3; W0; W1; AH_PIN(PW); AH_PIN(sacc); AH_SBAR(); } while (0)
#define AH_GAPB(MF, X, i) do { MF; X[i] = AH_EX(X[i]); X[i + 1] = AH_EX(X[i + 1]); X[i + 2] = AH_EX(X[i + 2]); X[i + 3] = AH_EX(X[i + 3]); AH_PIN(X); AH_SBAR(); } while (0)
#define AH_STEP(C0, C1, P0, P1, t, MASK, GK, GV, GL) do { AH_SBAR(); \
    AH_INIT(C0, C1, (t), mhat); \
    const ah_lds_cptr vp_ = vp0 + sl_prev; \
    AH_VRD(0); AH_SBAR(); float sacc = P0[0] + P0[1]; \
                       AH_GAPA(C0 = AH_MFMA(kf[0], qr[0], AH_CIN(C0)), P0[2], P0[3], P0[4], P0[5],     pw0[0] = AH_PKW(P0, 0),  pw0[1] = AH_PKW(P0, 2),  pw0); \
    AH_VRD(4); AH_SBAR(); AH_GAPA(C1 = AH_MFMA(kf[1], qr[0], AH_CIN(C1)), P0[6], P0[7], P0[8], P0[9],     pw0[2] = AH_PKW(P0, 4),  pw0[3] = AH_PKW(P0, 6),  pw0); \
    AH_VRD(1); AH_SBAR(); AH_GAPA(C0 = AH_MFMA(kf[2], qr[1], C0),    P0[10], P0[11], P0[12], P0[13], pw1[0] = AH_PKW(P0, 8),  pw1[1] = AH_PKW(P0, 10), pw1); \
    AH_VRD(5); AH_SBAR(); AH_GAPA(C1 = AH_MFMA(kf[3], qr[1], C1),    P0[14], P0[15], P1[0], P1[1],   pw1[2] = AH_PKW(P0, 12), pw1[3] = AH_PKW(P0, 14), pw1); \
    AH_VRD(2); AH_SBAR(); AH_GAPA(C0 = AH_MFMA(kf[4], qr[2], C0),    P1[2], P1[3], P1[4], P1[5],     pw2[0] = AH_PKW(P1, 0),  pw2[1] = AH_PKW(P1, 2),  pw2); \
    AH_VRD(6); AH_SBAR(); AH_GAPA(C1 = AH_MFMA(kf[5], qr[2], C1),    P1[6], P1[7], P1[8], P1[9],     pw2[2] = AH_PKW(P1, 4),  pw2[3] = AH_PKW(P1, 6),  pw2); \
    AH_VRD(3); AH_SBAR(); AH_GAPA(C0 = AH_MFMA(kf[6], qr[3], C0),    P1[10], P1[11], P1[12], P1[13], pw3[0] = AH_PKW(P1, 8),  pw3[1] = AH_PKW(P1, 10), pw3); \
    AH_VRD(7); AH_SBAR(); AH_GAPA(C1 = AH_MFMA(kf[7], qr[3], C1),    P1[14], P1[15], 0.f, 0.f,       pw3[2] = AH_PKW(P1, 12), pw3[3] = AH_PKW(P1, 14), pw3); \
    l_reg += sacc; \
    if (GK) AH_DMA_K((t) + 3, sl_cur); if (GV) AH_DMA_V((t) + 1, sl_next); \
    if (MASK) ah_cmask(C0, C1, 3 - (t), qrel, hi); \
    { const float rm = (TYPE == 2) ? ah_rowmax(C0, C1) : ah_rowmax(C0, C1) - mhat; resc = false;        \
      if (__builtin_expect(__any(rm > AH_THR), 0)) { const float dl = __builtin_fmaxf(rm, 0.f); mhat += dl;        \
          fres = __builtin_amdgcn_exp2f(-dl); l_reg *= fres; resc = true; \
          if (TYPE == 2) { _Pragma("unroll") for (int r_ = 0; r_ < 16; ++r_) { C0[r_] -= dl; C1[r_] -= dl; } } } } \
    const float nmh = -mhat; (void)nmh; AH_SBAR(); \
    AH_GAPB(o[0] = AH_MFMA(AH_VFR(0), AH_PAF(0), o[0]), C0, 0);              AH_GAPB(o[1] = AH_MFMA(AH_VFR(4), AH_PAF(0), o[1]), C0, 4); \
    AH_KRD(GL, 0); AH_GAPB(o[0] = AH_MFMA(AH_VFR(1), AH_PAF(1), o[0]), C0, 8);  AH_KRD(GL, 1); AH_GAPB(o[1] = AH_MFMA(AH_VFR(5), AH_PAF(1), o[1]), C0, 12); \
    AH_KRD(GL, 2); AH_GAPB(o[0] = AH_MFMA(AH_VFR(2), AH_PAF(2), o[0]), C1, 0);  AH_KRD(GL, 3); AH_GAPB(o[1] = AH_MFMA(AH_VFR(6), AH_PAF(2), o[1]), C1, 4); \
    AH_GAPB(o[0] = AH_MFMA(AH_VFR(3), AH_PAF(3), o[0]), C1, 8);              AH_GAPB(o[1] = AH_MFMA(AH_VFR(7), AH_PAF(3), o[1]), C1, 12); \
  } while (0)
#define AH_ENDW(tt) do { if ((tt) + 3 < NT) { AH_WAIT_BAR(2); } else if ((tt) + 2 < NT) { AH_WAIT_BAR(1); } else { AH_WAIT_BAR(0); } } while (0)
#define AH_PEELED_PAIR() do { \
    AH_STEP(pB0, pB1, pA0, pA1, t, (TYPE == 2 && t < 4), (t + 3 < NT), (t + 1 < NT), (t + 1 < NT));             AH_ENDW(t);     AH_RESC(); AH_ROT(); \
    AH_STEP(pA0, pA1, pB0, pB1, t + 1, (TYPE == 2 && t + 1 < 4), (t + 4 < NT), (t + 2 < NT), (t + 2 < NT));     AH_ENDW(t + 1); AH_RESC(); AH_ROT(); } while (0)
  int t = 1;
  if (TYPE == 2) { for (; t < 5 && t + 1 < NT; t += 2) AH_PEELED_PAIR(); }
  for (; t + 5 < NT; t += 2) {
    AH_STEP(pB0, pB1, pA0, pA1, t, false, true, true, true);     AH_WAIT_BAR(2); AH_RESC(); AH_ROT();
    AH_STEP(pA0, pA1, pB0, pB1, t + 1, false, true, true, true); AH_WAIT_BAR(2); AH_RESC(); AH_ROT();
  }
  for (; t + 1 < NT; t += 2) AH_PEELED_PAIR();
  AH_STEP(pB0, pB1, pA0, pA1, NT - 1, (TYPE == 2 && NT == 4), false, false, false); AH_RESC();
  {
    float sacc = pB0[0] + pB0[1];
#pragma unroll
    for (int r = 2; r < 16; ++r) sacc += pB0[r];
#pragma unroll
    for (int r = 0; r < 16; ++r) sacc += pB1[r];
    l_reg += sacc;
    pw0 = (u32x4){AH_PKW(pB0, 0), AH_PKW(pB0, 2), AH_PKW(pB0, 4), AH_PKW(pB0, 6)}; pw1 = (u32x4){AH_PKW(pB0, 8), AH_PKW(pB0, 10), AH_PKW(pB0, 12), AH_PKW(pB0, 14)};
    pw2 = (u32x4){AH_PKW(pB1, 0), AH_PKW(pB1, 2), AH_PKW(pB1, 4), AH_PKW(pB1, 6)}; pw3 = (u32x4){AH_PKW(pB1, 8), AH_PKW(pB1, 10), AH_PKW(pB1, 12), AH_PKW(pB1, 14)};
    const ah_lds_cptr vp_ = vp0 + sl_cur;
#pragma unroll
    for (int i = 0; i < 8; ++i) AH_VRD(i);
    o[0] = AH_MFMA(AH_VFR(0), AH_PAF(0), o[0]); o[1] = AH_MFMA(AH_VFR(4), AH_PAF(0), o[1]); o[0] = AH_MFMA(AH_VFR(1), AH_PAF(1), o[0]); o[1] = AH_MFMA(AH_VFR(5), AH_PAF(1), o[1]);
    o[0] = AH_MFMA(AH_VFR(2), AH_PAF(2), o[0]); o[1] = AH_MFMA(AH_VFR(6), AH_PAF(2), o[1]); o[0] = AH_MFMA(AH_VFR(3), AH_PAF(3), o[0]); o[1] = AH_MFMA(AH_VFR(7), AH_PAF(3), o[1]);
  }
  const float ltot = l_reg + __shfl_xor(l_reg, 32);
  const float inv = 1.0f / ltot;
  bf16_t* dst = p.HN + (tb + q0 + qrel) * DM + ((TYPE == 0) ? 768 : 384) + hd * 64;
#pragma unroll
  for (int dt = 0; dt < 2; ++dt)
#pragma unroll
    for (int gq = 0; gq < 4; ++gq) {
      uint2 ov;
      ov.x = pack2(o[dt][4 * gq + 0] * inv, o[dt][4 * gq + 1] * inv);
      ov.y = pack2(o[dt][4 * gq + 2] * inv, o[dt][4 * gq + 3] * inv);
      *(uint2*)(dst + 32 * dt + 8 * gq + 4 * hi) = ov;
    }
  asm volatile("s_waitcnt vmcnt(0) lgkmcnt(0)\n\ts_barrier" ::: "memory");
#undef AH_DMA_K
#undef AH_TA
#undef AH_DMA_V
#undef AH_ROT
#undef AH_INIT
#undef AH_CIN
#undef AH_EX
#undef AH_RESC
#undef AH_PKW
#undef AH_PAF
#undef AH_VFR
#undef AH_VRD
#undef AH_KRD
#undef AH_GAPA
#undef AH_GAPB
#undef AH_STEP
#undef AH_ENDW
#undef AH_PEELED_PAIR
}

#define AD_KB 0
#define AD_VB 49152
template <int KCH2>
DI void ad_kload2(bf16x8* kf, ah_lds_cptr kp, int d0) {
  kf[2 * d0] = *(const __attribute__((address_space(3))) bf16x8*)(kp + d0 * KCH2);
  kf[2 * d0 + 1] = *(const __attribute__((address_space(3))) bf16x8*)(kp + d0 * KCH2 + 512);
}
DI void ad_lmask(f32x16& c, int klo_h, int off) {
#pragma unroll
  for (int r = 0; r < 16; ++r) if (off + (r & 3) + 8 * (r >> 2) < klo_h) c[r] = -INFINITY;
}
DI void ad_umask(f32x16& c, int khi_h, int off) {
#pragma unroll
  for (int r = 0; r < 16; ++r) if (off + (r & 3) + 8 * (r >> 2) > khi_h) c[r] = -INFINITY;
}
DI float ad_rowmax16(const f32x16& p0) {
  float a = AH_MX3(p0[0], p0[1], p0[2]), b = AH_MX3(p0[3], p0[4], p0[5]);
  a = AH_MX3(a, p0[6], p0[7]); b = AH_MX3(b, p0[8], p0[9]); a = AH_MX3(a, p0[10], p0[11]); b = AH_MX3(b, p0[12], p0[13]); a = AH_MX3(a, p0[14], p0[15]);
  const float m = __builtin_fmaxf(a, b);
  auto rr = __builtin_amdgcn_permlane32_swap(__float_as_uint(m), __float_as_uint(m), false, false);
  return __builtin_fmaxf(__uint_as_float(rr[0]), __uint_as_float(rr[1]));
}

DI void attn_unit_dil(const int tid_, const Params& p, char* lds, int b, int hd, int m, int c, int res) {
  const int tid = tid_, lane = tid & 63, r32 = lane & 31, hi = lane >> 5;
  const int wid = __builtin_amdgcn_readfirstlane(tid >> 6);
  const size_t tb = (size_t)b * SEQ;
  const int d = (c == 0) ? 1 : (c == 1 ? 4 : 16);
  const bf16_t* Q = p.QKV + ((size_t)hd * T_TOK + tb) * 64;
  const char* Kc = (const char*)(p.QKV + ((size_t)(6 + hd) * T_TOK + tb) * 64);
  const char* Vc = (const char*)(p.QKV + ((size_t)(12 + hd) * T_TOK + tb) * 64);
  const float slope2 = alibi_slope(2 * hd) * (float)d * LOG2E;
  constexpr int AD_KCH2 = 12288, AD_VDH = 24576;
  const unsigned lds0 = (unsigned)(size_t)lds;
  {
    const unsigned koff = (unsigned)(lane * d * 128 + wid * 16);
    const unsigned voff = (unsigned)((16 * (wid & 3) + (lane >> 2)) * d * 128 + (wid >> 2) * 64 + (lane & 3) * 16);
    const unsigned kdst = lds0 + AD_KB + wid * 6144, vdst = lds0 + AD_VB + (wid >> 2) * 24576 + (wid & 3) * 1024;
#pragma unroll
    for (int i = 0; i < 6; ++i) {
      const int ie = (m == 0 && i < 2) ? 2 : i;
      const size_t rowb = ((size_t)((256 * m - 128 + 64 * ie) * d + res)) * 128;
      dma16_saddr(Kc + rowb, koff, kdst + i * 1024);
      dma16_saddr(Vc + rowb, voff, vdst + i * 4096);
    }
  }
  const int qsub = 256 * m + wid * 32 + r32;
  const size_t tok = tb + (size_t)qsub * d + res;
  bf16x8 qr[4];
#pragma unroll
  for (int d0 = 0; d0 < 4; ++d0) qr[d0] = *(const bf16x8*)(Q + ((size_t)qsub * d + res) * 64 + d0 * 16 + hi * 8);
  const int lb = (m == 0 && wid < 4) ? 128 - 32 * wid : 0;
  const ah_lds_cptr kp0 = (ah_lds_cptr)lds + AD_KB + hi * 6144 + (wid * 32 + r32) * 16;
  const ah_lds_cptr vp0 = (ah_lds_cptr)lds + AD_VB + ((lane >> 4) & 1) * 32 + (lane & 3) * 8 + (wid * 32 + 4 * hi + ((lane & 15) >> 2)) * 64;
  float mhat = 0.f, l_reg = 0.f, fres = 1.f;
  f32x16 o[2];
#pragma unroll
  for (int i = 0; i < 16; ++i) { o[0][i] = 0.f; o[1][i] = 0.f; }
  const float qposh = (float)(128 + r32 - 4 * hi);
  bool resc = false;
  f32x16 pA0, pA1, pB0, pB1;
  bf16x8 kf[8];
  s16x4 vlo[8], vhi[8];
  u32x4 pw0, pw1, pw2, pw3;
#define AD_INIT(C, u, koffs, ref) do { const float s_ = -slope2 * (qposh - (float)(64 * (u) + (koffs))) - (ref); \
    _Pragma("unroll") for (int i_ = 0; i_ < 16; ++i_) C[i_] = __builtin_fmaf(slope2, (float)((i_ & 3) + 8 * (i_ >> 2)), s_); } while (0)
#define AD_RESC() do { if (resc) { _Pragma("unroll") for (int r_ = 0; r_ < 16; ++r_) { o[0][r_] *= fres; o[1][r_] *= fres; } } } while (0)
#define AD_PKW(P, i) pack2(P[i], P[i + 1])
#define AD_PAF(k) __builtin_bit_cast(bf16x8, pw##k)
#define AD_VFR(i) (bf16x8){vlo[i][0], vlo[i][1], vlo[i][2], vlo[i][3], vhi[i][0], vhi[i][1], vhi[i][2], vhi[i][3]}
#define AD_VRD(i) do { vlo[i] = ah_vtr(vp_ + (((i) >> 2) * AD_VDH + ((i) & 3) * 1024)); vhi[i] = ah_vtr(vp_ + (((i) >> 2) * AD_VDH + ((i) & 3) * 1024 + 512)); } while (0)
#define AD_KRD(G, u, d0) do { if (G) { ad_kload2<AD_KCH2>(kf, kp0 + ((u) + 1) * 1024, d0); AH_SBAR(); } } while (0)
#define AD_GAPA(MF, a0, a1, a2, a3, W0, W1, PW) do { MF; sacc += a0; sacc += a1; sacc += a2; sacc += a3; W0; W1; AH_PIN(PW); AH_PIN(sacc); AH_SBAR(); } while (0)
#define AD_GAPB(MF, EXPS, X, i) do { MF; if (EXPS) { X[i] = __builtin_amdgcn_exp2f(X[i]); X[i + 1] = __builtin_amdgcn_exp2f(X[i + 1]); X[i + 2] = __builtin_amdgcn_exp2f(X[i + 2]); X[i + 3] = __builtin_amdgcn_exp2f(X[i + 3]); AH_PIN(X); } AH_SBAR(); } while (0)
#define AD_MF(G, x) do { if (G) { x; } } while (0)
#define AD_STEP(C0, C1, P0, P1, u, HALF, GL) do { AH_SBAR(); \
    AD_INIT(C0, (u), 0, mhat); if (!(HALF)) AD_INIT(C1, (u), 32, mhat); \
    const ah_lds_cptr vp_ = vp0 + ((u) - 1) * 4096; \
    AD_VRD(0); AH_SBAR(); float sacc = P0[0] + P0[1]; \
                          AD_GAPA(C0 = AH_MFMA(kf[0], qr[0], C0), P0[2], P0[3], P0[4], P0[5],     pw0[0] = AD_PKW(P0, 0),  pw0[1] = AD_PKW(P0, 2),  pw0); \
    AD_VRD(4); AH_SBAR(); AD_GAPA(AD_MF(!(HALF), C1 = AH_MFMA(kf[1], qr[0], C1)), P0[6], P0[7], P0[8], P0[9],     pw0[2] = AD_PKW(P0, 4),  pw0[3] = AD_PKW(P0, 6),  pw0); \
    AD_VRD(1); AH_SBAR(); AD_GAPA(C0 = AH_MFMA(kf[2], qr[1], C0),    P0[10], P0[11], P0[12], P0[13], pw1[0] = AD_PKW(P0, 8),  pw1[1] = AD_PKW(P0, 10), pw1); \
    AD_VRD(5); AH_SBAR(); AD_GAPA(AD_MF(!(HALF), C1 = AH_MFMA(kf[3], qr[1], C1)),    P0[14], P0[15], P1[0], P1[1],   pw1[2] = AD_PKW(P0, 12), pw1[3] = AD_PKW(P0, 14), pw1); \
    AD_VRD(2); AH_SBAR(); AD_GAPA(C0 = AH_MFMA(kf[4], qr[2], C0),    P1[2], P1[3], P1[4], P1[5],     pw2[0] = AD_PKW(P1, 0),  pw2[1] = AD_PKW(P1, 2),  pw2); \
    AD_VRD(6); AH_SBAR(); AD_GAPA(AD_MF(!(HALF), C1 = AH_MFMA(kf[5], qr[2], C1)),    P1[6], P1[7], P1[8], P1[9],     pw2[2] = AD_PKW(P1, 4),  pw2[3] = AD_PKW(P1, 6),  pw2); \
    AD_VRD(3); AH_SBAR(); AD_GAPA(C0 = AH_MFMA(kf[6], qr[3], C0),    P1[10], P1[11], P1[12], P1[13], pw3[0] = AD_PKW(P1, 8),  pw3[1] = AD_PKW(P1, 10), pw3); \
    AD_VRD(7); AH_SBAR(); AD_GAPA(AD_MF(!(HALF), C1 = AH_MFMA(kf[7], qr[3], C1)),    P1[14], P1[15], 0.f, 0.f,       pw3[2] = AD_PKW(P1, 12), pw3[3] = AD_PKW(P1, 14), pw3); \
    l_reg += sacc; \
    if (HALF) ad_umask(C0, r32 - 4 * hi, 0); \
    else if (lb > 64) { ad_lmask(C0, lb - 64 - 4 * hi, 0); ad_lmask(C1, lb - 64 - 4 * hi, 32); } \
    { const float rm = (HALF) ? ad_rowmax16(C0) : ah_rowmax(C0, C1); resc = false; \
      if (__builtin_expect(__any(rm > AH_THR), 0)) { const float dl = __builtin_fmaxf(rm, 0.f); mhat += dl; \
          fres = __builtin_amdgcn_exp2f(-dl); l_reg *= fres; resc = true; \
          _Pragma("unroll") for (int r_ = 0; r_ < 16; ++r_) { C0[r_] -= dl; if (!(HALF)) C1[r_] -= dl; } } } \
    AH_SBAR(); \
    AD_GAPB(o[0] = AH_MFMA(AD_VFR(0), AD_PAF(0), o[0]), true, C0, 0);                      AD_GAPB(o[1] = AH_MFMA(AD_VFR(4), AD_PAF(0), o[1]), true, C0, 4); \
    AD_KRD(GL, u, 0); AD_GAPB(o[0] = AH_MFMA(AD_VFR(1), AD_PAF(1), o[0]), true, C0, 8);  AD_KRD(GL, u, 1); AD_GAPB(o[1] = AH_MFMA(AD_VFR(5), AD_PAF(1), o[1]), true, C0, 12); \
    AD_KRD(GL, u, 2); AD_GAPB(o[0] = AH_MFMA(AD_VFR(2), AD_PAF(2), o[0]), !(HALF), C1, 0);  AD_KRD(GL, u, 3); AD_GAPB(o[1] = AH_MFMA(AD_VFR(6), AD_PAF(2), o[1]), !(HALF), C1, 4); \
    AD_GAPB(o[0] = AH_MFMA(AD_VFR(3), AD_PAF(3), o[0]), !(HALF), C1, 8);                   AD_GAPB(o[1] = AH_MFMA(AD_VFR(7), AD_PAF(3), o[1]), !(HALF), C1, 12); \
  } while (0)
  asm volatile("s_waitcnt vmcnt(0) lgkmcnt(0)\n\ts_barrier" ::: "memory");
#pragma unroll
  for (int d0 = 0; d0 < 4; ++d0) ad_kload2<AD_KCH2>(kf, kp0, d0);
  AD_INIT(pA0, 0, 0, 0.f); AD_INIT(pA1, 0, 32, 0.f);
  pA0 = AH_MFMA(kf[0], qr[0], pA0); pA1 = AH_MFMA(kf[1], qr[0], pA1); pA0 = AH_MFMA(kf[2], qr[1], pA0); pA1 = AH_MFMA(kf[3], qr[1], pA1);
  pA0 = AH_MFMA(kf[4], qr[2], pA0); pA1 = AH_MFMA(kf[5], qr[2], pA1); pA0 = AH_MFMA(kf[6], qr[3], pA0); pA1 = AH_MFMA(kf[7], qr[3], pA1);
  {
    const int klo = (r32 > lb ? r32 : lb) - 4 * hi;
    ad_lmask(pA0, klo, 0);
    if (lb > 32) ad_lmask(pA1, klo, 32);
    const float rm = ah_rowmax(pA0, pA1);
    mhat = __builtin_fmaxf(rm, -1000.0f);
    const float nm0 = -mhat;
#pragma unroll
    for (int r = 0; r < 16; ++r) { pA0[r] = __builtin_amdgcn_exp2f(pA0[r] + nm0); pA1[r] = __builtin_amdgcn_exp2f(pA1[r] + nm0); }
  }
#pragma unroll
  for (int d0 = 0; d0 < 4; ++d0) ad_kload2<AD_KCH2>(kf, kp0 + 1024, d0);
  AD_STEP(pB0, pB1, pA0, pA1, 1, false, true); AD_RESC();
  AD_STEP(pA0, pA1, pB0, pB1, 2, true, false);  AD_RESC();
  {
    float sacc = pA0[0] + pA0[1];
#pragma unroll
    for (int r = 2; r < 16; ++r) sacc += pA0[r];
    l_reg += sacc;
    pw0 = (u32x4){AD_PKW(pA0, 0), AD_PKW(pA0, 2), AD_PKW(pA0, 4), AD_PKW(pA0, 6)}; pw1 = (u32x4){AD_PKW(pA0, 8), AD_PKW(pA0, 10), AD_PKW(pA0, 12), AD_PKW(pA0, 14)};
    const ah_lds_cptr vp_ = vp0 + 2 * 4096;
    AD_VRD(0); AD_VRD(4); AD_VRD(1); AD_VRD(5);
    o[0] = AH_MFMA(AD_VFR(0), AD_PAF(0), o[0]); o[1] = AH_MFMA(AD_VFR(4), AD_PAF(0), o[1]); o[0] = AH_MFMA(AD_VFR(1), AD_PAF(1), o[0]); o[1] = AH_MFMA(AD_VFR(5), AD_PAF(1), o[1]);
  }
  const float ltot = l_reg + __shfl_xor(l_reg, 32);
  const float inv = 1.0f / ltot;
  bf16_t* dst = p.DILO + ((size_t)c * T_TOK + tok) * 384 + hd * 64;
  if (hi == 0) p.LSE2[((size_t)c * T_TOK + tok) * 6 + hd] = mhat + __builtin_amdgcn_logf(ltot);
#pragma unroll
  for (int dt = 0; dt < 2; ++dt)
#pragma unroll
    for (int gq = 0; gq < 4; ++gq) {
      uint2 ov;
      ov.x = pack2(o[dt][4 * gq + 0] * inv, o[dt][4 * gq + 1] * inv);
      ov.y = pack2(o[dt][4 * gq + 2] * inv, o[dt][4 * gq + 3] * inv);
      *(uint2*)(dst + 32 * dt + 8 * gq + 4 * hi) = ov;
    }
  asm volatile("s_waitcnt lgkmcnt(0)\n\ts_barrier" ::: "memory");
}

DI void attn_mem_resident(const int tid_, const Params& p, char* lds, int b, int hd, int m_first, int NQ) {
  const int tid = tid_, lane = tid & 63, r32 = lane & 31, hi = lane >> 5;
  const int wid = __builtin_amdgcn_readfirstlane(tid >> 6);
  const size_t tb = (size_t)b * SEQ;
  const bf16_t* Q = p.QKV + ((size_t)(36 + hd) * T_TOK + tb) * 64;
  const char* Kc = (const char*)(p.KVM + ((size_t)hd * (NB * MEMLEN) + (size_t)b * MEMLEN) * 64);
  const char* Vc = (const char*)(p.KVM + ((size_t)(4 + hd) * (NB * MEMLEN) + (size_t)b * MEMLEN) * 64);
  constexpr float slope2 = 0.f;
  constexpr int AD_KCH2 = 8192, AD_VDH = 16384, MEM_VB = 32768;
  constexpr int lb = 0;
  const unsigned lds0 = (unsigned)(size_t)lds;
  {
    const unsigned koff = (unsigned)(lane * 128 + wid * 16);
    const unsigned voff = (unsigned)((16 * (wid & 3) + (lane >> 2)) * 128 + (wid >> 2) * 64 + (lane & 3) * 16);
    const unsigned kdst = lds0 + wid * 4096, vdst = lds0 + MEM_VB + (wid >> 2) * 16384 + (wid & 3) * 1024;
#pragma unroll
    for (int i = 0; i < 4; ++i) {
      dma16_saddr(Kc + (size_t)i * 64 * 128, koff, kdst + i * 1024);
      dma16_saddr(Vc + (size_t)i * 64 * 128, voff, vdst + i * 4096);
    }
  }
  const ah_lds_cptr kp0 = (ah_lds_cptr)lds + hi * 4096 + r32 * 16;
  const ah_lds_cptr vp0 = (ah_lds_cptr)lds + MEM_VB + ((lane >> 4) & 1) * 32 + (lane & 3) * 8 + (4 * hi + ((lane & 15) >> 2)) * 64;
  const float qposh = 0.f;
  asm volatile("s_waitcnt vmcnt(0) lgkmcnt(0)\n\ts_barrier" ::: "memory");
#pragma unroll 1
  for (int qu = 0; qu < NQ; ++qu) {
    const int qrow = 256 * (m_first + qu) + wid * 32 + r32;
    bf16x8 qr[4];
#pragma unroll
    for (int d0 = 0; d0 < 4; ++d0) qr[d0] = *(const bf16x8*)(Q + (size_t)qrow * 64 + d0 * 16 + hi * 8);
    float mhat = 0.f, l_reg = 0.f, fres = 1.f;
    f32x16 o[2];
#pragma unroll
    for (int i = 0; i < 16; ++i) { o[0][i] = 0.f; o[1][i] = 0.f; }
    bool resc = false;
    f32x16 pA0, pA1, pB0, pB1;
    bf16x8 kf[8];
    s16x4 vlo[8], vhi[8];
    u32x4 pw0, pw1, pw2, pw3;
#pragma unroll
    for (int d0 = 0; d0 < 4; ++d0) ad_kload2<AD_KCH2>(kf, kp0, d0);
    AD_INIT(pA0, 0, 0, 0.f); AD_INIT(pA1, 0, 32, 0.f);
    pA0 = AH_MFMA(kf[0], qr[0], pA0); pA1 = AH_MFMA(kf[1], qr[0], pA1); pA0 = AH_MFMA(kf[2], qr[1], pA0); pA1 = AH_MFMA(kf[3], qr[1], pA1);
    pA0 = AH_MFMA(kf[4], qr[2], pA0); pA1 = AH_MFMA(kf[5], qr[2], pA1); pA0 = AH_MFMA(kf[6], qr[3], pA0); pA1 = AH_MFMA(kf[7], qr[3], pA1);
    {
      mhat = ah_rowmax(pA0, pA1);
      const float nm0 = -mhat;
#pragma unroll
      for (int r = 0; r < 16; ++r) { pA0[r] = __builtin_amdgcn_exp2f(pA0[r] + nm0); pA1[r] = __builtin_amdgcn_exp2f(pA1[r] + nm0); }
    }
#pragma unroll
    for (int d0 = 0; d0 < 4; ++d0) ad_kload2<AD_KCH2>(kf, kp0 + 1024, d0);
    AD_STEP(pB0, pB1, pA0, pA1, 1, false, true); AD_RESC();
    AD_STEP(pA0, pA1, pB0, pB1, 2, false, true); AD_RESC();
    AD_STEP(pB0, pB1, pA0, pA1, 3, false, false); AD_RESC();
    {
      float sacc = pB0[0] + pB0[1];
#pragma unroll
      for (int r = 2; r < 16; ++r) sacc += pB0[r];
#pragma unroll
      for (int r = 0; r < 16; ++r) sacc += pB1[r];
      l_reg += sacc;
      pw0 = (u32x4){AD_PKW(pB0, 0), AD_PKW(pB0, 2), AD_PKW(pB0, 4), AD_PKW(pB0, 6)}; pw1 = (u32x4){AD_PKW(pB0, 8), AD_PKW(pB0, 10), AD_PKW(pB0, 12), AD_PKW(pB0, 14)};
      pw2 = (u32x4){AD_PKW(pB1, 0), AD_PKW(pB1, 2), AD_PKW(pB1, 4), AD_PKW(pB1, 6)}; pw3 = (u32x4){AD_PKW(pB1, 8), AD_PKW(pB1, 10), AD_PKW(pB1, 12), AD_PKW(pB1, 14)};
      const ah_lds_cptr vp_ = vp0 + 3 * 4096;
#pragma unroll
      for (int i = 0; i < 8; ++i) AD_VRD(i);
      o[0] = AH_MFMA(AD_VFR(0), AD_PAF(0), o[0]); o[1] = AH_MFMA(AD_VFR(4), AD_PAF(0), o[1]); o[0] = AH_MFMA(AD_VFR(1), AD_PAF(1), o[0]); o[1] = AH_MFMA(AD_VFR(5), AD_PAF(1), o[1]);
      o[0] = AH_MFMA(AD_VFR(2), AD_PAF(2), o[0]); o[1] = AH_MFMA(AD_VFR(6), AD_PAF(2), o[1]); o[0] = AH_MFMA(AD_VFR(3), AD_PAF(3), o[0]); o[1] = AH_MFMA(AD_VFR(7), AD_PAF(3), o[1]);
    }
    const float ltot = l_reg + __shfl_xor(l_reg, 32);
    const float inv = 1.0f / ltot;
    bf16_t* dst = p.HN + (tb + qrow) * DM + 768 + hd * 64;
#pragma unroll
    for (int dt = 0; dt < 2; ++dt)
#pragma unroll
      for (int gq = 0; gq < 4; ++gq) {
        uint2 ov;
        ov.x = pack2(o[dt][4 * gq + 0] * inv, o[dt][4 * gq + 1] * inv);
        ov.y = pack2(o[dt][4 * gq + 2] * inv, o[dt][4 * gq + 3] * inv);
        *(uint2*)(dst + 32 * dt + 8 * gq + 4 * hi) = ov;
      }
  }
  asm volatile("s_waitcnt lgkmcnt(0)\n\ts_barrier" ::: "memory");
#undef AD_INIT
#undef AD_RESC
#undef AD_PKW
#undef AD_PAF
#undef AD_VFR
#undef AD_VRD
#undef AD_KRD
#undef AD_GAPA
#undef AD_GAPB
#undef AD_MF
#undef AD_STEP
}

DI void phase_attn_mfma(const int tid_, const Params& p, int bid, int nblk, char* lds, int PARTS = 7) {
  const int x = bid & 7, j = bid >> 3, nb = nblk >> 3;
  const int n_moba = 12 * 16, n_dil = 12 * 48;
  (void)PARTS;
  for (int k = 0; k * nb < n_moba; ++k) {
    const int li = k * nb + ((k & 1) ? (nb - 1 - j) : j);
    if (li >= n_moba) continue;
    const int m = 15 - (li & 15), bh = (li >> 4) * 8 + x;
    int tq = tid_; asm volatile("" : "+v"(tq));
    attn_unit_hi<2>(tq, p, lds, bh / 6, bh % 6, m);
  }
  for (int si = bid; si < NB * 4 * 4; si += nblk) {
    const int jj = si >> 3, pair = (jj >> 2) * 8 + (si & 7);
    int tm = tid_; asm volatile("" : "+v"(tm));
    attn_mem_resident(tm, p, lds, pair >> 2, pair & 3, 4 * (jj & 3), 4);
  }
  for (int k = 0; k * nb < n_dil; ++k) {
    const int it = k * nb + ((k & 1) ? (nb - 1 - j) : j);
    if (it >= n_dil) continue;
    const int q = it % 48, bh = (it / 48) * 8 + x;
    int c, m, res;
    if (q < 16) { c = 0; m = q; res = 0; }
    else if (q < 32) { c = 1; m = (q - 16) & 3; res = (q - 16) >> 2; }
    else { c = 2; m = 0; res = q - 32; }
    int td = tid_; asm volatile("" : "+v"(td));
    attn_unit_dil(td, p, lds, bh / 6, bh % 6, m, c, res);
  }
}

DI void groupnorm_rows(const int tid_, const Params& p, int row0, int nrows, int gw, int nw) {
  const int lane = tid_ & 63;
  const int grp = lane < 24 ? 0 : (lane < 48 ? 1 : 2);
  const float* gp = grp == 0 ? p.og_dil + lane * 16 : (grp == 1 ? p.og_moba + (lane - 24) * 16 : p.og_mem + (lane - 48) * 16);
  const float inv_n = grp == 2 ? 1.0f / 256.0f : 1.0f / 384.0f;
  for (int row = row0 + gw; row < row0 + nrows; row += nw) {
    bf16_t* yp = p.HN + (size_t)row * DM + lane * 16;
    const uint4 a = ((const uint4*)yp)[0], b = ((const uint4*)yp)[1];
    const unsigned w[8] = {a.x, a.y, a.z, a.w, b.x, b.y, b.z, b.w};
    float v[16];
#pragma unroll
    for (int j = 0; j < 8; ++j) { v[2 * j] = __uint_as_float(w[j] << 16); v[2 * j + 1] = __uint_as_float(w[j] & 0xffff0000u); }
    if (grp == 0) {
      float ls[3];
#pragma unroll
      for (int c = 0; c < 3; ++c) ls[c] = p.LSE2[((size_t)c * T_TOK + row) * 6 + (lane >> 2)];
      const float M = fmaxf(ls[0], fmaxf(ls[1], ls[2]));
      float wc[3], wsum = 0.f;
#pragma unroll
      for (int c = 0; c < 3; ++c) { wc[c] = __builtin_amdgcn_exp2f(ls[c] - M); wsum += wc[c]; }
      const float winv = 1.0f / wsum;
#pragma unroll
      for (int j = 0; j < 16; ++j) v[j] = 0.f;
#pragma unroll
      for (int c = 0; c < 3; ++c) {
        const bf16_t* dp = p.DILO + ((size_t)c * T_TOK + row) * 384 + lane * 16;
        const uint4 da = ((const uint4*)dp)[0], db = ((const uint4*)dp)[1];
        const unsigned dw[8] = {da.x, da.y, da.z, da.w, db.x, db.y, db.z, db.w};
        const float wgt = wc[c] * winv;
#pragma unroll
        for (int j = 0; j < 8; ++j) { v[2 * j] += wgt * __uint_as_float(dw[j] << 16); v[2 * j + 1] += wgt * __uint_as_float(dw[j] & 0xffff0000u); }
      }
    }
    float ss = 0.f;
#pragma unroll
    for (int j = 0; j < 16; ++j) ss += v[j] * v[j];
    const float s0 = wave_sum(grp == 0 ? ss : 0.f), s1 = wave_sum(grp == 1 ? ss : 0.f), s2 = wave_sum(grp == 2 ? ss : 0.f);
    const float tot = grp == 0 ? s0 : (grp == 1 ? s1 : s2);
    const float rinv = rsqrtf(tot * inv_n + 1e-6f);
    unsigned o[8];
#pragma unroll
    for (int j = 0; j < 8; ++j) o[j] = pack2(v[2 * j] * rinv * gp[2 * j], v[2 * j + 1] * rinv * gp[2 * j + 1]);
    ((uint4*)yp)[0] = make_uint4(o[0], o[1], o[2], o[3]);
    ((uint4*)yp)[1] = make_uint4(o[4], o[5], o[6], o[7]);
  }
}

DI unsigned f2key(float f) { const unsigned u = __float_as_uint(f); return u ^ ((unsigned)((int)u >> 31) | 0x80000000u); }
DI float key2f(unsigned k) { const unsigned u = (k & 0x80000000u) ? (k ^ 0x80000000u) : ~k; return __uint_as_float(u); }
DI void cex_desc(unsigned& a, unsigned& b) { const unsigned hi = a > b ? a : b, lo = a > b ? b : a; a = hi; b = lo; }
DI void sort16_desc(unsigned (&a)[16]) {
#pragma unroll
  for (int k = 2; k <= 16; k <<= 1)
#pragma unroll
    for (int j = k >> 1; j >= 1; j >>= 1)
#pragma unroll
      for (int i = 0; i < 16; ++i) {
        const int l = i ^ j;
        if (l > i) { if ((i & k) == 0) cex_desc(a[i], a[l]); else cex_desc(a[l], a[i]); }
      }
}
DI void bitonic_merge16_desc(unsigned (&a)[16]) {
#pragma unroll
  for (int j = 8; j >= 1; j >>= 1)
#pragma unroll
    for (int i = 0; i < 16; ++i) { const int l = i ^ j; if (l > i) cex_desc(a[i], a[l]); }
}
DI void merge_top16(unsigned (&L)[16], const unsigned (&S)[16]) {
#pragma unroll
  for (int i = 0; i < 16; ++i) L[i] = L[i] > S[15 - i] ? L[i] : S[15 - i];
  bitonic_merge16_desc(L);
}

DI void peerq_scores_topk(const int tid_, const char* SKl, const f32x16 (&acc)[4], unsigned (&L)[16]) {
  const int lane = tid_ & 63, r = lane & 31, h = lane >> 5;
  bf16x8 xf[4][2];
#pragma unroll
  for (int nt = 0; nt < 4; ++nt)
#pragma unroll
    for (int s2 = 0; s2 < 2; ++s2) {
      u32x4 pk;
#pragma unroll
      for (int j = 0; j < 4; ++j) pk[j] = pack2(acc[nt][8 * s2 + 2 * j], acc[nt][8 * s2 + 2 * j + 1]);
      xf[nt][s2] = __builtin_bit_cast(bf16x8, pk);
    }
#pragma unroll
  for (int j = 0; j < 16; ++j) L[j] = 0u;
#pragma unroll 1
  for (int kt = 0; kt < 4; ++kt) {
    f32x16 sc;
#pragma unroll
    for (int i = 0; i < 16; ++i) sc[i] = 0.f;
    const char* krow = SKl + (32 * kt + r) * 256;
    const int ksw = r & 15;
#pragma unroll
    for (int nt = 0; nt < 4; ++nt)
#pragma unroll
      for (int s2 = 0; s2 < 2; ++s2) {
        const u32x4 kk = *(const u32x4*)(krow + ((((nt * 2 + s2) * 2 + h) ^ ksw) << 4));
        sc = __builtin_amdgcn_mfma_f32_32x32x16_bf16(__builtin_bit_cast(bf16x8, kk), xf[nt][s2], sc, 0, 0, 0);
      }
    unsigned S[16];
#pragma unroll
    for (int i = 0; i < 16; ++i) {
      const unsigned idx = (unsigned)(32 * kt + (i & 3) + 8 * (i >> 2) + 4 * h);
      S[i] = (f2key(sc[i]) & 0xffffff80u) | idx;
    }
    sort16_desc(S);
    merge_top16(L, S);
  }
  unsigned P[16];
#pragma unroll
  for (int j = 0; j < 16; ++j) {
    auto rr = __builtin_amdgcn_permlane32_swap(L[j], L[j], false, false);
    L[j] = rr[0]; P[j] = rr[1];
  }
  merge_top16(L, P);
}

DI void peerq_item(const int tid_, const Params& p, char* lds, int mt, int head) {
  const int tid = tid_, lane = tid & 63, w = tid >> 6, r = lane & 31, h = lane >> 5;
  f32x16 acc[8];
#pragma unroll
  for (int a = 0; a < 8; ++a)
#pragma unroll
    for (int i = 0; i < 16; ++i) acc[a][i] = 0.f;
  unsigned loff[4];
#pragma unroll
  for (int j = 0; j < 4; ++j) {
    const int row = 32 * w + 8 * j + (lane >> 3);
    loff[j] = (unsigned)((row * DM + (((lane & 7) ^ ((row >> 1) & 7)) << 3)) * 2);
  }
  const int wave_s = __builtin_amdgcn_readfirstlane(w);
  const unsigned lds0 = (unsigned)(size_t)lds + (unsigned)(wave_s * 32 * 128);
  const char* Ab = (const char*)(p.HN + (size_t)(mt * 256) * DM);
  const char* Bb = (const char*)(p.WqT + (size_t)(head * 256) * DM);
  asm volatile("s_waitcnt vmcnt(0)" ::: "memory");
  __syncthreads();
#pragma unroll
  for (int j = 0; j < 4; ++j) { dma16_saddr(Ab, loff[j], lds0 + j * 1024); dma16_saddr(Bb, loff[j], lds0 + 32768 + j * 1024); }
  const unsigned sk_lds = (unsigned)(size_t)lds + (unsigned)(wave_s * 4096);
  {
    int l2 = lane; asm volatile("" : "+v"(l2));
    const bf16_t* sub1 = karg()->SUB1;
#pragma unroll
    for (int j = 0; j < 4; ++j) {
      const int pc = (wave_s * 4 + j) * 64 + l2, row = pc >> 4;
      dma16_saddr(sub1 + (size_t)head * 128 * 128, (unsigned)(row * 256 + (((pc & 15) ^ (row & 15)) << 4)), sk_lds + 2 * BIG_STAGE_BYTES + j * 1024);
    }
  }
  const int trow = 32 * w + r;
  const int toff = trow * 128, tsw = (trow >> 1) & 7, wsw = (r >> 1) & 7;
  for (int kt = 0; kt < 16; ++kt) {
    asm volatile("s_waitcnt vmcnt(0) lgkmcnt(0)" ::: "memory");
    __builtin_amdgcn_s_barrier();
    const char* Sc = lds + (kt & 1) * BIG_STAGE_BYTES;
    const unsigned ldn = lds0 + (unsigned)(((kt + 1) & 1) * BIG_STAGE_BYTES);
    const bool more = kt + 1 < 16;
    const char* An = Ab + (size_t)(kt + 1) * 128;
    const char* Bn = Bb + (size_t)(kt + 1) * 128;
#pragma unroll
    for (int s = 0; s < 4; ++s) {
      const bf16x8 tf = *(const bf16x8*)(Sc + toff + (((2 * s + h) ^ tsw) << 4));
      bf16x8 wf[4], wg[4];
#pragma unroll
      for (int nt = 0; nt < 4; ++nt) wf[nt] = *(const bf16x8*)(Sc + 32768 + (32 * nt + r) * 128 + (((2 * s + h) ^ wsw) << 4));
      if (more && s < 2) {
        dma16_saddr(An, loff[2 * s], ldn + (2 * s) * 1024); dma16_saddr(Bn, loff[2 * s], ldn + 32768 + (2 * s) * 1024);
        dma16_saddr(An, loff[2 * s + 1], ldn + (2 * s + 1) * 1024); dma16_saddr(Bn, loff[2 * s + 1], ldn + 32768 + (2 * s + 1) * 1024);
      }
#pragma unroll
      for (int nt = 0; nt < 4; ++nt) wg[nt] = *(const bf16x8*)(Sc + 32768 + (32 * (nt + 4) + r) * 128 + (((2 * s + h) ^ wsw) << 4));
#pragma unroll
      for (int nt = 0; nt < 4; ++nt) acc[nt] = __builtin_amdgcn_mfma_f32_32x32x16_bf16(wf[nt], tf, acc[nt], 0, 0, 0);
#pragma unroll
      for (int nt = 0; nt < 4; ++nt) acc[nt + 4] = __builtin_amdgcn_mfma_f32_32x32x16_bf16(wg[nt], tf, acc[nt + 4], 0, 0, 0);
      __builtin_amdgcn_sched_barrier(0);
    }
  }
  __syncthreads();
  {
    int l2 = lane; asm volatile("" : "+v"(l2));
    const bf16_t* sub2 = karg()->SUB2;
#pragma unroll
    for (int j = 0; j < 4; ++j) {
      const int pc = (wave_s * 4 + j) * 64 + l2, row = pc >> 4;
      dma16_saddr(sub2 + (size_t)head * 128 * 128, (unsigned)(row * 256 + (((pc & 15) ^ (row & 15)) << 4)), sk_lds + BIG_STAGE_BYTES + j * 1024);
    }
  }
  unsigned L0[16], L[16];
  {
    const f32x16 (&a0)[4] = *(const f32x16 (*)[4])&acc[0];
    peerq_scores_topk(tid_, lds + 2 * BIG_STAGE_BYTES, a0, L0);
    asm volatile("s_waitcnt vmcnt(0)" ::: "memory");
    __syncthreads();
    const f32x16 (&a1)[4] = *(const f32x16 (*)[4])&acc[4];
    peerq_scores_topk(tid_, lds + BIG_STAGE_BYTES, a1, L);
  }
  unsigned* stash0 = (unsigned*)lds + (32 * w + r) * 64 + 32 * h;
  unsigned* stash1 = stash0 + 16;
#pragma unroll
  for (int j = 0; j < 4; ++j) {
    *(u32x4*)(stash0 + 4 * j) = (u32x4){L0[4 * j], L0[4 * j + 1], L0[4 * j + 2], L0[4 * j + 3]};
    *(u32x4*)(stash1 + 4 * j) = (u32x4){L[4 * j], L[4 * j + 1], L[4 * j + 2], L[4 * j + 3]};
  }
  {
    float v1[16], v2[16];
#pragma unroll
    for (int j = 0; j < 16; ++j) { v1[j] = key2f(L0[j] & 0xffffff80u); v2[j] = key2f(L[j] & 0xffffff80u); }
    unsigned F[16], G[16];
#pragma unroll
    for (int j = 0; j < 16; ++j) F[j] = 0u;
#pragma unroll
    for (int grp = 0; grp < 4; ++grp) {
#pragma unroll
      for (int j = 0; j < 16; ++j) G[j] = 0u;
      int cnt = 0;
#pragma unroll
      for (int a = 0; a < 16; ++a)
#pragma unroll
        for (int b = 0; b < 16; ++b)
          if ((a + 1) * (b + 1) <= 16) {
            if ((cnt >> 4) == grp) G[cnt & 15] = (f2key(v1[a] + v2[b]) & 0xffffff00u) | (unsigned)(a * 16 + b);
            ++cnt;
          }
      sort16_desc(G);
      merge_top16(F, G);
    }
    const float mx = key2f(F[0] & 0xffffff00u);
    float e[16], den = 0.f;
    int ex[16];
#pragma unroll
    for (int j = 0; j < 16; ++j) {
      e[j] = __expf(key2f(F[j] & 0xffffff00u) - mx);
      den += e[j];
      const int a = (F[j] >> 4) & 15, b = F[j] & 15;
      const unsigned k1 = stash0[a], k2 = stash1[b];
      ex[j] = (int)((k1 & 127u) * 128u + (k2 & 127u));
    }
    const float inv = 1.0f / den;
    if (h == 0) {
      const size_t o = (size_t)(mt * 256 + 32 * w + r) * 128 + head * 16;
#pragma unroll
      for (int j = 0; j < 2; ++j)
        *(u32x4*)(p.PIDX + o + 8 * j) = (u32x4){(unsigned)ex[8 * j] | ((unsigned)ex[8 * j + 1] << 16), (unsigned)ex[8 * j + 2] | ((unsigned)ex[8 * j + 3] << 16),
                                                (unsigned)ex[8 * j + 4] | ((unsigned)ex[8 * j + 5] << 16), (unsigned)ex[8 * j + 6] | ((unsigned)ex[8 * j + 7] << 16)};
#pragma unroll
      for (int j = 0; j < 4; ++j)
        *(float4*)(p.PGATE + o + 4 * j) = make_float4(e[4 * j] * inv, e[4 * j + 1] * inv, e[4 * j + 2] * inv, e[4 * j + 3] * inv);
    }
  }
}

template <int CTRL>
DI int dpp_addi(int v) { return v + __builtin_amdgcn_update_dpp(0, v, CTRL, 0xf, 0xf, true); }
DI void phase_peer_u(const int tid_, const Params& p, int bid, int nblk) {
  const int lane = tid_ & 63, w = tid_ >> 6, g = lane >> 3, l8 = lane & 7;
  const int k = bid & 7, ws = (bid >> 3) * WPB + w, nws = (nblk >> 3) * WPB;
  const uint8_t* Us = p.U8s + (size_t)k * 16384 * 128;
  const unsigned lo16 = 16u * (unsigned)l8;
  bf16_t* PPk = (bf16_t*)p.PP + (size_t)k * T_TOK * 128;
  for (int G = ws; G < T_TOK / 8; G += nws) {
    const int t = 8 * G + g;
    const u32x4 xq = *(const u32x4*)(p.X8 + ((size_t)k * T_TOK + t) * 128 + 16 * l8);
    const float sx = p.SX[(size_t)t * 8 + k];
    const unsigned short* ip = p.PIDX + (size_t)t * 128;
#pragma unroll 1
    for (int c = 0; c < 8; ++c) {
      int idx[16];
#pragma unroll
      for (int j = 0; j < 2; ++j) {
        const u32x4 q = *(const u32x4*)(ip + 16 * c + 8 * j);
#pragma unroll
        for (int e = 0; e < 4; ++e) { idx[8 * j + 2 * e] = (int)(q[e] & 0xffffu); idx[8 * j + 2 * e + 1] = (int)(q[e] >> 16); }
      }
      u32x4 u[16];
#pragma unroll
      for (int i = 0; i < 16; ++i) u[i] = *(const u32x4*)(Us + (((unsigned)idx[i] << 7) + lo16));
      int o0 = 0, o1 = 0;
#pragma unroll
      for (int i = 0; i < 16; ++i) {
        int acc = 0;
#pragma unroll
        for (int d = 0; d < 4; ++d) acc = __builtin_amdgcn_sdot4((int)u[i][d], (int)xq[d], acc, false);
        acc = dpp_addi<0xB1>(acc);
        acc = dpp_addi<0x4E>(acc);
        acc = dpp_addi<0x141>(acc);
        if ((i >> 1) == l8) { if (i & 1) o1 = acc; else o0 = acc; }
      }
      *(unsigned*)(PPk + (size_t)t * 128 + 16 * c + 2 * l8) = pack2((float)o0 * sx, (float)o1 * sx);
    }
  }
}

DI void phase_peer_w(const int tid_, const Params& p, int bid, int nblk) {
  const int gt = bid * NTHREADS + tid_, nt = nblk * NTHREADS;
  for (int i = gt; i < T_TOK * 128 / 4; i += nt) {
    float4 s = make_float4(0.f, 0.f, 0.f, 0.f);
#pragma unroll
    for (int k = 0; k < 8; ++k) {
      const uint2 q = ((const uint2*)((const bf16_t*)p.PP + (size_t)k * T_TOK * 128))[i];
      s.x += __uint_as_float(q.x << 16); s.y += __uint_as_float(q.x & 0xffff0000u);
      s.z += __uint_as_float(q.y << 16); s.w += __uint_as_float(q.y & 0xffff0000u);
    }
    const float4 gte = ((const float4*)p.PGATE)[i];
    const uint2 ei = ((const uint2*)p.PIDX)[i];
    const int e4[4] = {(int)(ei.x & 0xffffu), (int)(ei.x >> 16), (int)(ei.y & 0xffffu), (int)(ei.y >> 16)};
    float a[4] = {s.x, s.y, s.z, s.w}, gg[4] = {gte.x, gte.y, gte.z, gte.w}, o[4];
    float mx = 0.f;
#pragma unroll
    for (int j = 0; j < 4; ++j) {
      const float v = a[j] * p.SU[e4[j]];
      o[j] = 0.5f * v * (1.0f + erff(v * 0.70710678118654752f)) * gg[j] * p.SV[e4[j]];
      mx = fmaxf(mx, fabsf(o[j]));
    }
    mx = max32(mx);
    const float inv = mx > 0.f ? 127.0f / mx : 0.f;
    const unsigned q = ((unsigned)__float2int_rn(o[0] * inv) & 0xffu) | (((unsigned)__float2int_rn(o[1] * inv) & 0xffu) << 8) |
                       (((unsigned)__float2int_rn(o[2] * inv) & 0xffu) << 16) | (((unsigned)__float2int_rn(o[3] * inv) & 0xffu) << 24);
    const int t = i >> 5;
    ((unsigned*)(p.PGATE + (size_t)t * 128))[i & 31] = q;
    if ((i & 31) == 0) p.SW[t] = mx * (1.0f / 127.0f);
  }
}

DI unsigned perm_b32(unsigned hi, unsigned lo, unsigned sel) { return __builtin_amdgcn_perm(hi, lo, sel); }
DI void phase_peer_v(const int tid_, const Params& p, int bid, int nblk) {
  const int lane = tid_ & 63, w = tid_ >> 6, g = lane >> 3, l8 = lane & 7;
  const int k = bid & 7, ws = (bid >> 3) * WPB + w, nws = (nblk >> 3) * WPB;
  const uint8_t* Vs = p.V8s + (size_t)k * 16384 * 128;
  const unsigned lo16 = 16u * (unsigned)l8;
  for (int G = ws; G < T_TOK / 8; G += nws) {
    const int t = 8 * G + g;
    const unsigned short* ip = p.PIDX + (size_t)t * 128;
    const unsigned* wq = (const unsigned*)(p.PGATE + (size_t)t * 128);
    const float sw = p.SW[t];
    int acc[16];
#pragma unroll
    for (int j = 0; j < 16; ++j) acc[j] = 0;
#pragma unroll 1
    for (int c = 0; c < 8; ++c) {
      int idx[16];
#pragma unroll
      for (int j = 0; j < 2; ++j) {
        const u32x4 q = *(const u32x4*)(ip + 16 * c + 8 * j);
#pragma unroll
        for (int e = 0; e < 4; ++e) { idx[8 * j + 2 * e] = (int)(q[e] & 0xffffu); idx[8 * j + 2 * e + 1] = (int)(q[e] >> 16); }
      }
      const u32x4 w4 = *(const u32x4*)(wq + 4 * c);
      u32x4 v[16];
#pragma unroll
      for (int i = 0; i < 16; ++i) v[i] = *(const u32x4*)(Vs + (((unsigned)idx[i] << 7) + lo16));
#pragma unroll
      for (int q4 = 0; q4 < 4; ++q4) {
#pragma unroll
        for (int d = 0; d < 4; ++d) {
          const unsigned x0 = v[4 * q4][d], x1 = v[4 * q4 + 1][d], x2 = v[4 * q4 + 2][d], x3 = v[4 * q4 + 3][d];
          const unsigned t01l = perm_b32(x1, x0, 0x05010400u);
          const unsigned t01h = perm_b32(x1, x0, 0x07030602u);
          const unsigned t23l = perm_b32(x3, x2, 0x05010400u);
          const unsigned t23h = perm_b32(x3, x2, 0x07030602u);
          const unsigned y0 = perm_b32(t23l, t01l, 0x05040100u);
          const unsigned y1 = perm_b32(t23l, t01l, 0x07060302u);
          const unsigned y2 = perm_b32(t23h, t01h, 0x05040100u);
          const unsigned y3 = perm_b32(t23h, t01h, 0x07060302u);
          acc[4 * d + 0] = __builtin_amdgcn_sdot4((int)y0, (int)w4[q4], acc[4 * d + 0], false);
          acc[4 * d + 1] = __builtin_amdgcn_sdot4((int)y1, (int)w4[q4], acc[4 * d + 1], false);
          acc[4 * d + 2] = __builtin_amdgcn_sdot4((int)y2, (int)w4[q4], acc[4 * d + 2], false);
          acc[4 * d + 3] = __builtin_amdgcn_sdot4((int)y3, (int)w4[q4], acc[4 * d + 3], false);
        }
      }
    }
    float4* op = (float4*)(p.out + (size_t)t * DM + 128 * k + 16 * l8);
    const u32x4* xp = (const u32x4*)(X1B(p) + (size_t)t * DM + 128 * k + 16 * l8);
    const u32x4 xa = xp[0], xb = xp[1];
    const unsigned xw[8] = {xa[0], xa[1], xa[2], xa[3], xb[0], xb[1], xb[2], xb[3]};
#pragma unroll
    for (int j = 0; j < 4; ++j) {
      float4 o;
      o.x = __uint_as_float(xw[2 * j] << 16) + sw * (float)acc[4 * j];
      o.y = __uint_as_float(xw[2 * j] & 0xffff0000u) + sw * (float)acc[4 * j + 1];
      o.z = __uint_as_float(xw[2 * j + 1] << 16) + sw * (float)acc[4 * j + 2];
      o.w = __uint_as_float(xw[2 * j + 1] & 0xffff0000u) + sw * (float)acc[4 * j + 3];
      op[j] = o;
    }
  }
}

#define XB_TMO      128
#define XB_XCNT(j)  (256  + 64 * (j))
#define XB_XSUB(j)  (1280 + 64 * (j))
#define XB_XGEN(j)  (2304 + 64 * (j))
#define XB_TOP      3328
#define XB_TOPGEN   3392
#define XCD_BAR_WORDS 3456
#define XB_SPIN_CAP (1u << 20)
#define LAS __attribute__((address_space(3)))
DI unsigned xb_ld(unsigned* p) { return __hip_atomic_load(p, __ATOMIC_RELAXED, __HIP_MEMORY_SCOPE_AGENT); }
DI unsigned xb_add(unsigned* p, unsigned v) { return __hip_atomic_fetch_add(p, v, __ATOMIC_RELAXED, __HIP_MEMORY_SCOPE_AGENT); }
DI unsigned xb_xcc_id() { return (unsigned)__builtin_amdgcn_s_getreg((3 << 11) | 20) & 0xFu; }
#define XB_SPIN(cond, bar) do { unsigned _sp = 0; while (cond) { __builtin_amdgcn_s_sleep(1); \
    if ((++_sp & 255u) == 0u) { if (xb_ld(&(bar)[XB_TMO])) break; if (_sp > XB_SPIN_CAP) { atomicAdd(&(bar)[XB_TMO], 1u); break; } } } } while (0)
struct XcdBarrier { unsigned packed; };
DI XcdBarrier xcd_barrier_post(const int tid_, unsigned* bar) {
  XcdBarrier b; b.packed = xb_xcc_id();
  if (tid_ == 0) (void)xb_add(&bar[XB_XCNT(b.packed)], 1u);
  return b;
}
DI void xcd_barrier_complete(unsigned* bar, unsigned x, unsigned& nloc, unsigned& nx) {
  const unsigned G = gridDim.x * gridDim.y * gridDim.z;
  unsigned sum, cnt, mine, sp = 0u;
  for (;;) {
    sum = 0u; cnt = 0u; mine = 0u;
#pragma unroll
    for (unsigned j = 0; j < 16; ++j) { const unsigned c = xb_ld(&bar[XB_XCNT(j)]); sum += c; cnt += (c > 0u) ? 1u : 0u; mine = (j == x) ? c : mine; }
    if (sum == G) break;
    __builtin_amdgcn_s_sleep(1);
    if ((++sp & 255u) == 0u) { if (xb_ld(&bar[XB_TMO])) break; if (sp > XB_SPIN_CAP) { atomicAdd(&bar[XB_TMO], 1u); break; } }
  }
  nloc = mine > 0u ? mine : 1u; nx = cnt > 0u ? cnt : 1u;
}
DI void xcd_barrier(const int tid_, XcdBarrier& b) {
  unsigned* bar = karg()->bar;
  asm volatile("s_waitcnt vmcnt(0)" ::: "memory");
  __syncthreads();
  if ((b.packed >> 9) == 0u) {
    unsigned nl, nxx;
    xcd_barrier_complete(bar, b.packed & 15u, nl, nxx);
    b.packed = (unsigned)__builtin_amdgcn_readfirstlane((int)((b.packed & 15u) | (nxx << 4) | (nl << 9)));
  }
  if (tid_ == 0) {
    __builtin_amdgcn_s_waitcnt(0);
    const unsigned x = b.packed & 15u, nx = (b.packed >> 4) & 31u, nloc = b.packed >> 9;
    const unsigned old = xb_add(&bar[XB_XSUB(x)], 1u);
    const unsigned gen = old / nloc;
    if (old + 1u == (gen + 1u) * nloc) {
      __builtin_amdgcn_fence(__ATOMIC_RELEASE, "agent");
      asm volatile("s_waitcnt vmcnt(0)" ::: "memory");
      const unsigned og = xb_add(&bar[XB_TOP], 1u);
      const unsigned tg = og / nx;
      if (og + 1u == (tg + 1u) * nx) xb_add(&bar[XB_TOPGEN], 1u);
      else XB_SPIN(xb_ld(&bar[XB_TOPGEN]) == tg, bar);
      __builtin_amdgcn_fence(__ATOMIC_ACQUIRE, "agent");
      xb_add(&bar[XB_XGEN(x)], 1u);
      asm volatile("s_waitcnt vmcnt(0)" ::: "memory");
    } else {
      XB_SPIN(xb_ld(&bar[XB_XGEN(x)]) == gen, bar);
      __builtin_amdgcn_fence(__ATOMIC_ACQUIRE, "agent");
      asm volatile("s_waitcnt vmcnt(0)" ::: "memory");
    }
  }
  __syncthreads();
}

DI void norm2_rows(const int tid_, const Params& p, int row0, int nrows, int gw, int nw) {
  const int lane = tid_ & 63;
  for (int row = row0 + gw; row < row0 + nrows; row += nw) {
    const uint2* s2 = (const uint2*)(X1B(p) + (size_t)row * DM);
    float4 v[4];
    float ss = 0.f;
#pragma unroll
    for (int i = 0; i < 4; ++i) {
      const uint2 q2 = s2[lane + 64 * i];
      v[i] = make_float4(__uint_as_float(q2.x << 16), __uint_as_float(q2.x & 0xffff0000u), __uint_as_float(q2.y << 16), __uint_as_float(q2.y & 0xffff0000u));
      ss += v[i].x * v[i].x + v[i].y * v[i].y + v[i].z * v[i].z + v[i].w * v[i].w;
    }
    ss = wave_sum(ss);
    const float rinv = rsqrtf(ss * (1.0f / DM) + 1e-6f);
#pragma unroll
    for (int i = 0; i < 4; ++i) {
      const float4 gg = ((const float4*)p.g_ffn)[lane + 64 * i];
      const float a = v[i].x * rinv * gg.x, b = v[i].y * rinv * gg.y, c = v[i].z * rinv * gg.z, d = v[i].w * rinv * gg.w;
      uint2 o;
      o.x = pack2(a, b); o.y = pack2(c, d);
      ((uint2*)(p.HN + (size_t)row * DM))[lane + 64 * i] = o;
      float mx = fmaxf(fmaxf(fabsf(a), fabsf(b)), fmaxf(fabsf(c), fabsf(d)));
      mx = max32(mx);
      const float inv = mx > 0.f ? 127.0f / mx : 0.f;
      const unsigned q = ((unsigned)__float2int_rn(a * inv) & 0xffu) | (((unsigned)__float2int_rn(b * inv) & 0xffu) << 8) |
                         (((unsigned)__float2int_rn(c * inv) & 0xffu) << 16) | (((unsigned)__float2int_rn(d * inv) & 0xffu) << 24);
      const int slice = 2 * i + (lane >> 5);
      *(unsigned*)(p.X8 + ((size_t)slice * T_TOK + row) * 128 + 4 * (lane & 31)) = q;
      if ((lane & 31) == 0) p.SX[(size_t)row * 8 + slice] = mx * (1.0f / 127.0f);
    }
  }
}

DI void phase_post(const int tid_, const Params& p, int bid, int nblk, char* lds) {
  for (int mt = bid; mt < T_TOK / 256; mt += nblk) {
    int ta = tid_; asm volatile("" : "+v"(ta));
    groupnorm_rows(ta, p, mt * 256, 256, ta >> 6, WPB);
    asm volatile("s_waitcnt vmcnt(0)" ::: "memory");
    __syncthreads();
    int tb = tid_; asm volatile("" : "+v"(tb));
#pragma unroll 1
    for (int nt_ = 0; nt_ < 4 * PP_OUT; ++nt_) {
      const int nt = nt_ & 3;
      f32x16 acc[4][2];
      gemm_big(tb, p.HN, p.WoutT, DM, mt * 256, nt * 256, lds, acc);
#pragma unroll 1
      for (int pass = 0; pass < 2; ++pass) {
        gemm_big_dump(tb, acc, pass, lds);
        const float* Cs = (const float*)lds;
#pragma unroll 2
        for (int it2 = 0; it2 < 16; ++it2) {
          const int task = tb + NTHREADS * it2;
          const int row = task >> 5, c4 = task & 31;
          const float4 c = *(const float4*)(Cs + row * 132 + c4 * 4);
          const size_t off = (size_t)(mt * 256 + row) * DM + nt * 256 + pass * 128 + c4 * 4;
          const float4 xv = *(const float4*)(p.x + off);
          uint2 o2; o2.x = pack2(xv.x + c.x, xv.y + c.y); o2.y = pack2(xv.z + c.z, xv.w + c.w);
          *(uint2*)(X1B(p) + off) = o2;
        }
      }
    }
    asm volatile("s_waitcnt vmcnt(0)" ::: "memory");
    __syncthreads();
    int tc = tid_; asm volatile("" : "+v"(tc));
#pragma unroll 1
    for (int rep_ = 0; rep_ < PP_N2; ++rep_) norm2_rows(tc, p, mt * 256, 256, tc >> 6, WPB);
    asm volatile("s_waitcnt vmcnt(0)" ::: "memory");
    __syncthreads();
#pragma unroll 1
    for (int head = 0; head < 8 * PP_PQ; ++head) { int td = tid_; asm volatile("" : "+v"(td)); peerq_item(td, p, lds, mt, head & 7); }
  }
}

#define NPHASE 7
template <int PH>
DI void run_phase(const int tid_, const Params& p, int bid, int nblk, char* lds, int parts = 7) {
  if (PH == 0) phase_prep(tid_, p, bid, nblk);
  if (PH == 1) phase_proj(tid_, p, bid, nblk, lds);
  if (PH == 2) phase_attn_mfma(tid_, p, bid, nblk, lds, parts);
  if (PH == 3) phase_post(tid_, p, bid, nblk, lds);
  if (PH == 4) phase_peer_u(tid_, p, bid, nblk);
  if (PH == 5) phase_peer_w(tid_, p, bid, nblk);
  if (PH == 6) phase_peer_v(tid_, p, bid, nblk);
}
template <int PH>
DI void mega_step(int bid, int nblk, char* lds, cg::grid_group& grid, XcdBarrier& xb, int wave_u) {
  unsigned z_ = 0u; asm volatile("" : "+v"(z_));
  int tid_ = wave_u * 64 + (int)__builtin_amdgcn_mbcnt_hi(~0u, __builtin_amdgcn_mbcnt_lo(~0u, z_));
  asm volatile("" : "+v"(tid_));
#if defined(__HIP_DEVICE_COMPILE__)
  KernargPtr pp = (KernargPtr)__builtin_amdgcn_kernarg_segment_ptr();
  asm volatile("" : "+s"(pp));
  const Params p = *pp;
#else
  const Params p{};
#endif
  if (DUP_PHASE == PH) {
    int nrep = 2; asm volatile("" : "+s"(nrep));
    for (int rep = 0; rep < nrep; ++rep) { if (rep) xcd_barrier(tid_, xb); run_phase<PH>(tid_, p, bid, nblk, lds, rep ? 7 : DUP_PARTS); }
  } else
#ifdef ONLY_PHASE
  if (PH == ONLY_PHASE)
#endif
  run_phase<PH>(tid_, p, bid, nblk, lds);
  if (PH == 0) grid.sync();
  else if (PH + 1 < NPHASE) xcd_barrier(tid_, xb);
}
__global__ void __launch_bounds__(NTHREADS, 2) mega(Params p0) {
  __shared__ __attribute__((aligned(16))) char lds[LDS_BYTES];
  const int bid = blockIdx.x, nblk = gridDim.x;
  cg::grid_group grid = cg::this_grid();
  const int tid_ = (int)__builtin_amdgcn_workitem_id_x();
  XcdBarrier xb = xcd_barrier_post(tid_, p0.bar);
  const int wave_u = __builtin_amdgcn_readfirstlane(tid_ >> 6);
  mega_step<0>(bid, nblk, lds, grid, xb, wave_u);
  mega_step<1>(bid, nblk, lds, grid, xb, wave_u);
  mega_step<2>(bid, nblk, lds, grid, xb, wave_u);
  mega_step<3>(bid, nblk, lds, grid, xb, wave_u);
  mega_step<4>(bid, nblk, lds, grid, xb, wave_u);
  mega_step<5>(bid, nblk, lds, grid, xb, wave_u);
  mega_step<6>(bid, nblk, lds, grid, xb, wave_u);
}

static inline size_t align_up(size_t v) { return (v + 255) & ~(size_t)255; }

extern "C" void kernel_launch(void* const* d_in, const int* in_sizes, int n_in, void* d_out, int out_size, void* d_ws,
                              size_t ws_size, hipStream_t stream) {
  Params p{};
  const float* const* in = (const float* const*)d_in;
  p.x = in[0]; p.mem = in[1]; p.g_mix = in[2]; p.w_in = in[3]; p.qg_dil = in[4]; p.kg_dil = in[5]; p.qg_moba = in[6];
  p.kg_moba = in[7]; p.qg_mem = in[8]; p.kg_mem = in[9]; p.g_memtok = in[10]; p.w_mem_kv = in[11]; p.og_dil = in[12];
  p.og_moba = in[13]; p.og_mem = in[14]; p.w_out = in[15]; p.g_ffn = in[16]; p.w_peer_q = in[17]; p.sub1 = in[18];
  p.sub2 = in[19]; p.peer_u = in[20]; p.peer_v = in[21];
  p.out = (float*)d_out;
  char* w = (char*)d_ws;
  size_t off = 0;
  auto take = [&](size_t bytes) { char* r = w + off; off = align_up(off + bytes); return r; };
  p.bar = (unsigned*)take((size_t)XCD_BAR_WORDS * 4);
  p.HN = (bf16_t*)take((size_t)T_TOK * DM * 2);
  p.QKV = (bf16_t*)take((size_t)NGRP * T_TOK * 64 * 2);
  p.MEMN = (bf16_t*)take((size_t)NB * MEMLEN * DM * 2);
  p.KVM = (bf16_t*)take((size_t)8 * NB * MEMLEN * 64 * 2);
  p.WinT = (bf16_t*)take((size_t)INW * DM * 2);
  p.WoutT = (bf16_t*)take((size_t)DM * DM * 2);
  p.WqT = (bf16_t*)take((size_t)2048 * DM * 2);
  p.WmkvT = (bf16_t*)take((size_t)512 * DM * 2);
  p.SUB1 = (bf16_t*)take((size_t)8 * 128 * 128 * 2);
  p.SUB2 = (bf16_t*)take((size_t)8 * 128 * 128 * 2);
  p.KMEAN = (float*)take((size_t)NB * 6 * 16 * 64 * 4);
  p.PIDX = (unsigned short*)take((size_t)T_TOK * 128 * 2);
  p.PGATE = (float*)take((size_t)T_TOK * 128 * 4);
  p.DILO = (bf16_t*)take((size_t)3 * T_TOK * 384 * 2);
  p.LSE2 = (float*)take((size_t)3 * T_TOK * 6 * 4);
  p.U8s = (uint8_t*)take((size_t)16384 * DM);
  p.V8s = (uint8_t*)take((size_t)16384 * DM);
  p.PP = (float*)p.QKV;
  p.SU = (float*)take((size_t)16384 * 4);
  p.SV = (float*)take((size_t)16384 * 4);
  p.SW = (float*)take((size_t)T_TOK * 4);
  p.X8 = (uint8_t*)p.DILO;
  p.SX = (float*)((char*)p.DILO + (size_t)T_TOK * DM);
  if (off > ws_size) { fprintf(stderr, "workspace too small: need %zu have %zu\n", off, ws_size); return; }

  static int grid_blocks = 0;
  if (!grid_blocks) {
    int dev = 0, cus = 0, per_cu = 0;
    (void)hipGetDevice(&dev);
    (void)hipDeviceGetAttribute(&cus, hipDeviceAttributeMultiprocessorCount, dev);
    (void)hipOccupancyMaxActiveBlocksPerMultiprocessor(&per_cu, mega, NTHREADS, 0);
    if (per_cu < 1) fprintf(stderr, "occupancy query says the kernel does not fit a CU\n");
    grid_blocks = cus & ~7;
  }
  (void)hipMemsetAsync(p.bar, 0, (size_t)XCD_BAR_WORDS * 4, stream);
  void* args[] = {&p};
  hipError_t e = hipLaunchCooperativeKernel((void*)mega, dim3(grid_blocks), dim3(NTHREADS), args, 0, stream);
  if (e != hipSuccess) fprintf(stderr, "cooperative launch failed: %s (grid %d)\n", hipGetErrorString(e), grid_blocks);
}
```

```cpp
#include <hip/hip_runtime.h>
#include <hip/hip_cooperative_groups.h>
#include <stdint.h>
#include <stdio.h>
namespace cg = cooperative_groups;

#ifndef DUP_PHASE
#define DUP_PHASE -1
#endif
#ifndef DUP_PARTS
#define DUP_PARTS 7
#endif
#ifndef PROBE_TYPE
#define PROBE_TYPE 0
#endif
#ifndef PP_OUT
#define PP_OUT 1
#endif
#ifndef PP_N2
#define PP_N2 1
#endif
#ifndef PP_PQ
#define PP_PQ 1
#endif

typedef unsigned short bf16_t;
typedef __attribute__((ext_vector_type(8))) short bf16x8;
typedef __attribute__((ext_vector_type(16))) float f32x16;
typedef __attribute__((ext_vector_type(4))) float f32x4;
typedef __attribute__((ext_vector_type(4))) unsigned u32x4;
typedef __attribute__((ext_vector_type(2))) unsigned u32x2;
typedef __attribute__((ext_vector_type(4))) short s16x4;
#define DI __device__ __forceinline__
#define LDSP __attribute__((address_space(3)))

#define T_TOK 65536
#define SEQ 4096
#define NB 16
#define DM 1024
#define INW 2560
#define NGRP 40
#define MEMLEN 256
#define NTHREADS 512
#define WPB 8
#define STAGE_BYTES 49152
#define RING_BYTES (3 * STAGE_BYTES)
#define LDS_BYTES 163840

struct Params {
  const float *x, *mem, *g_mix, *w_in, *qg_dil, *kg_dil, *qg_moba, *kg_moba, *qg_mem, *kg_mem, *g_memtok, *w_mem_kv,
      *og_dil, *og_moba, *og_mem, *w_out, *g_ffn, *w_peer_q, *sub1, *sub2, *peer_u, *peer_v;
  float* out;
  unsigned* bar;
  bf16_t *HN;
  bf16_t *QKV;
  bf16_t *MEMN;
  bf16_t *KVM;
  bf16_t *WinT, *WoutT, *WqT, *WmkvT;
  bf16_t *SUB1, *SUB2;
  uint8_t *U8s, *V8s;
  float *SU, *SV;
  float *SW;
  uint8_t *X8;
  float *SX;
  float *PP;
  float *KMEAN;
  bf16_t *DILO;
  float *LSE2;
  unsigned short *PIDX;
  float *PGATE;
};

typedef const __attribute__((address_space(4))) Params* KernargPtr;
DI KernargPtr karg() {
#if defined(__HIP_DEVICE_COMPILE__)
  KernargPtr q = (KernargPtr)__builtin_amdgcn_kernarg_segment_ptr();
  asm volatile("" : "+s"(q));
  return q;
#else
  return nullptr;
#endif
}
DI float bf2f(bf16_t v) { return __uint_as_float(((unsigned)v) << 16); }
typedef __attribute__((ext_vector_type(2))) __bf16 bf16v2;
typedef __attribute__((ext_vector_type(2))) float f32x2;
DI unsigned pack2(float a, float b) { f32x2 v = {a, b}; return __builtin_bit_cast(unsigned, __builtin_convertvector(v, bf16v2)); }
template <int CTRL>
DI float dppf(float v) { return __int_as_float(__builtin_amdgcn_update_dpp(0, __float_as_int(v), CTRL, 0xf, 0xf, true)); }
DI float sum8(float v) { v += dppf<0xB1>(v); v += dppf<0x4E>(v); v += dppf<0x141>(v); return v; }
DI float sum16(float v) { v = sum8(v); v += dppf<0x140>(v); return v; }
DI float max16(float v) { v = fmaxf(v, dppf<0xB1>(v)); v = fmaxf(v, dppf<0x4E>(v)); v = fmaxf(v, dppf<0x141>(v)); v = fmaxf(v, dppf<0x140>(v)); return v; }
DI float sum32(float v) {
  v = sum16(v);
  auto rr = __builtin_amdgcn_permlane16_swap(__float_as_uint(v), __float_as_uint(v), false, false);
  return __uint_as_float(rr[0]) + __uint_as_float(rr[1]);
}
DI float max32(float v) {
  v = max16(v);
  auto rr = __builtin_amdgcn_permlane16_swap(__float_as_uint(v), __float_as_uint(v), false, false);
  return fmaxf(__uint_as_float(rr[0]), __uint_as_float(rr[1]));
}
DI float wave_sum(float v) {
  v = sum32(v);
  auto rr = __builtin_amdgcn_permlane32_swap(__float_as_uint(v), __float_as_uint(v), false, false);
  return __uint_as_float(rr[0]) + __uint_as_float(rr[1]);
}
DI float wave_max(float v) {
  v = max32(v);
  auto rr = __builtin_amdgcn_permlane32_swap(__float_as_uint(v), __float_as_uint(v), false, false);
  return fmaxf(__uint_as_float(rr[0]), __uint_as_float(rr[1]));
}
DI int crow(int i, int h) { return (i & 3) + 8 * (i >> 2) + 4 * h; }

DI void rmsnorm_rows(const int tid_, const float* __restrict__ src, const float* __restrict__ g, bf16_t* __restrict__ dst, int rows, int gw, int nw) {
  const int lane = tid_ & 63;
  float4 gg[4];
#pragma unroll
  for (int i = 0; i < 4; ++i) gg[i] = ((const float4*)g)[lane + 64 * i];
  for (int row = gw; row < rows; row += 4 * nw) {
    f32x4 t_[4][4];
#pragma unroll
    for (int u = 0; u < 4; ++u) {
      const f32x4* s4 = (const f32x4*)(src + (size_t)min(row + u * nw, rows - 1) * DM);
#pragma unroll
      for (int i = 0; i < 4; ++i) t_[u][i] = __builtin_nontemporal_load(s4 + lane + 64 * i);
    }
    __builtin_amdgcn_sched_barrier(0);
#pragma unroll
    for (int u = 0; u < 4; ++u) {
      const int ru = row + u * nw;
      float ss = 0.f;
#pragma unroll
      for (int i = 0; i < 4; ++i) ss += t_[u][i][0] * t_[u][i][0] + t_[u][i][1] * t_[u][i][1] + t_[u][i][2] * t_[u][i][2] + t_[u][i][3] * t_[u][i][3];
      ss = wave_sum(ss);
      const float rinv = rsqrtf(ss * (1.0f / DM) + 1e-6f);
#pragma unroll
      for (int i = 0; i < 4; ++i) {
        uint2 o;
        o.x = pack2(t_[u][i][0] * rinv * gg[i].x, t_[u][i][1] * rinv * gg[i].y);
        o.y = pack2(t_[u][i][2] * rinv * gg[i].z, t_[u][i][3] * rinv * gg[i].w);
        if (ru < rows) ((uint2*)(dst + (size_t)ru * DM))[lane + 64 * i] = o;
      }
    }
  }
}
DI void transpose_w(const float* __restrict__ W, bf16_t* __restrict__ Wt, int K, int N, int gt, int nt) {
  const int total = N * (K / 8);
  for (int idx = gt; idx < total; idx += nt) {
    const int n = idx % N, kc = idx / N;
    unsigned o[4];
#pragma unroll
    for (int j = 0; j < 4; ++j) o[j] = pack2(W[(size_t)(kc * 8 + 2 * j) * N + n], W[(size_t)(kc * 8 + 2 * j + 1) * N + n]);
    *(uint4*)(Wt + (size_t)n * K + kc * 8) = make_uint4(o[0], o[1], o[2], o[3]);
  }
}
DI void convert_u_int8(const int tid_, const float* __restrict__ src, uint8_t* __restrict__ dst, float* __restrict__ su, int gw, int nw) {
  const int lane = tid_ & 63;
  for (int e0 = gw; e0 < 16384; e0 += 8 * nw) {
    float4 v[8][4];
#pragma unroll
    for (int u = 0; u < 8; ++u) {
      const float4* s4 = (const float4*)(src + (size_t)min(e0 + u * nw, 16383) * DM);
#pragma unroll
      for (int i = 0; i < 4; ++i) v[u][i] = s4[lane + 64 * i];
    }
    __builtin_amdgcn_sched_barrier(0);
#pragma unroll
    for (int u = 0; u < 8; ++u) {
      const int e = min(e0 + u * nw, 16383);
      float mx = 0.f;
#pragma unroll
      for (int i = 0; i < 4; ++i) mx = fmaxf(mx, fmaxf(fmaxf(fabsf(v[u][i].x), fabsf(v[u][i].y)), fmaxf(fabsf(v[u][i].z), fabsf(v[u][i].w))));
      mx = wave_max(mx);
      const float inv = mx > 0.f ? 127.0f / mx : 0.f;
      if (lane == 0) su[e] = mx * (1.0f / 127.0f);
#pragma unroll
      for (int i = 0; i < 4; ++i) {
        const unsigned q = ((unsigned)__float2int_rn(v[u][i].x * inv) & 0xffu) | (((unsigned)__float2int_rn(v[u][i].y * inv) & 0xffu) << 8) |
                           (((unsigned)__float2int_rn(v[u][i].z * inv) & 0xffu) << 16) | (((unsigned)__float2int_rn(v[u][i].w * inv) & 0xffu) << 24);
        const int slice = 2 * i + (lane >> 5);
        *(unsigned*)(dst + ((size_t)slice * 16384 + e) * 128 + 4 * (lane & 31)) = q;
      }
    }
  }
}
DI void convert_subkeys(const float* __restrict__ src, bf16_t* __restrict__ dst, int gt, int nt_) {
  for (int i = gt; i < 8 * 128 * 16; i += nt_) {
    const int grp = i & 15, row = i >> 4;
    const int h = grp & 1, ns = grp >> 1;
    const float* sp = src + (size_t)row * 128 + 16 * ns + 4 * h;
    const float4 a = *(const float4*)sp, b = *(const float4*)(sp + 8);
    *(uint4*)(dst + (size_t)row * 128 + grp * 8) = make_uint4(pack2(a.x, a.y), pack2(a.z, a.w), pack2(b.x, b.y), pack2(b.z, b.w));
  }
}
DI void phase_prep(const int tid_, const Params& p, int bid, int nblk) {
  const int gt = bid * NTHREADS + tid_, nt = nblk * NTHREADS;
  const int gw = gt >> 6, nw = nt >> 6;
  rmsnorm_rows(tid_, p.x, p.g_mix, p.HN, T_TOK, gw, nw);
  rmsnorm_rows(tid_, p.mem, p.g_memtok, p.MEMN, NB * MEMLEN, gw, nw);
  transpose_w(p.w_in, p.WinT, DM, INW, gt, nt);
  transpose_w(p.w_out, p.WoutT, DM, DM, gt, nt);
  transpose_w(p.w_peer_q, p.WqT, DM, 2048, gt, nt);
  transpose_w(p.w_mem_kv, p.WmkvT, DM, 512, gt, nt);
  convert_subkeys(p.sub1, p.SUB1, gt, nt);
  convert_subkeys(p.sub2, p.SUB2, gt, nt);
  convert_u_int8(tid_, p.peer_u, p.U8s, p.SU, gw, nw);
  convert_u_int8(tid_, p.peer_v, p.V8s, p.SV, gw, nw);
}

DI void gemm_stage(const int tid_, const bf16_t* __restrict__ A, const bf16_t* __restrict__ Bt, int K, int m0, int n0, int k0, char* stg) {
  const int lane = tid_ & 63, wave = tid_ >> 6;
  const int lr = lane >> 3, spos = lane & 7;
#pragma unroll
  for (int j = 0; j < 4; ++j) {
    const int row = 32 * wave + 8 * j + lr;
    const int sw = (spos ^ ((row >> 1) & 7)) << 3;
    __builtin_amdgcn_global_load_lds((const unsigned*)(A + (size_t)(m0 + row) * K + k0 + sw),
                                     (LDSP unsigned*)(stg + (32 * wave + 8 * j) * 128 + lane * 16), 16, 0, 0);
  }
#pragma unroll
  for (int j = 0; j < 2; ++j) {
    const int row = 16 * wave + 8 * j + lr;
    const int sw = (spos ^ ((row >> 1) & 7)) << 3;
    __builtin_amdgcn_global_load_lds((const unsigned*)(Bt + (size_t)(n0 + row) * K + k0 + sw),
                                     (LDSP unsigned*)(stg + 32768 + (16 * wave + 8 * j) * 128 + lane * 16), 16, 0, 0);
  }
}
#define RING_WAIT(more_in_flight)                                                     \
  do {                                                                                \
    if (more_in_flight) asm volatile("s_waitcnt vmcnt(6) lgkmcnt(0)" ::: "memory");   \
    else asm volatile("s_waitcnt vmcnt(0) lgkmcnt(0)" ::: "memory");                  \
    __builtin_amdgcn_s_barrier();                                                     \
  } while (0)

#define BIG_STAGE_BYTES 65536
DI void dma16_saddr(const void* sbase, unsigned voff, unsigned lds_dst) {
  unsigned keep;
  asm volatile("s_mov_b32 %0, m0\n\ts_mov_b32 m0, %3\n\ts_nop 0\n\tglobal_load_lds_dwordx4 %1, %2\n\ts_mov_b32 m0, %0"
               : "=&s"(keep) : "v"(voff), "s"(sbase), "s"(lds_dst) : "memory");
}
DI void gemm_big(const int tid_, const bf16_t* __restrict__ A, const bf16_t* __restrict__ Bt, int K, int m0, int n0, char* lds, f32x16 (&acc)[4][2]) {
  const int tid = tid_, lane = tid & 63, wave = tid >> 6;
  const int wm = wave >> 2, wn = wave & 3, r = lane & 31, h = lane >> 5;
#pragma unroll
  for (int a = 0; a < 4; ++a)
#pragma unroll
    for (int b = 0; b < 2; ++b)
#pragma unroll
      for (int i = 0; i < 16; ++i) acc[a][b][i] = 0.f;
  const int nk = K >> 6;
  unsigned loff[4];
#pragma unroll
  for (int j = 0; j < 4; ++j) {
    const int row = 32 * wave + 8 * j + (lane >> 3);
    loff[j] = (unsigned)((row * K + (((lane & 7) ^ ((row >> 1) & 7)) << 3)) * 2);
  }
  const int wave_s = __builtin_amdgcn_readfirstlane(wave);
  const unsigned lds0 = (unsigned)(size_t)lds + (unsigned)(wave_s * 32 * 128);
  const char* Ab = (const char*)(A + (size_t)m0 * K);
  const char* Bb = (const char*)(Bt + (size_t)n0 * K);
  asm volatile("s_waitcnt vmcnt(0)" ::: "memory");
  __syncthreads();
#pragma unroll
  for (int j = 0; j < 4; ++j) { dma16_saddr(Ab, loff[j], lds0 + j * 1024); dma16_saddr(Bb, loff[j], lds0 + 32768 + j * 1024); }
  int aoff[4], boff[2];
  const int fsw = (r >> 1) & 7;
#pragma unroll
  for (int t = 0; t < 4; ++t) aoff[t] = (wm * 128 + t * 32 + r) * 128;
#pragma unroll
  for (int t = 0; t < 2; ++t) boff[t] = 32768 + (wn * 64 + t * 32 + r) * 128;
  for (int kt = 0; kt < nk; ++kt) {
    asm volatile("s_waitcnt vmcnt(0) lgkmcnt(0)" ::: "memory");
    __builtin_amdgcn_s_barrier();
    const char* Sc = lds + (kt & 1) * BIG_STAGE_BYTES;
    const unsigned ldn = lds0 + (unsigned)(((kt + 1) & 1) * BIG_STAGE_BYTES);
    const bool more = kt + 1 < nk;
    const char* An = Ab + (size_t)(kt + 1) * 128;
    const char* Bn = Bb + (size_t)(kt + 1) * 128;
    bf16x8 af[2][4], bfr[2][2];
    {
      const int co = (h ^ fsw) << 4;
#pragma unroll
      for (int t = 0; t < 4; ++t) af[0][t] = *(const bf16x8*)(Sc + aoff[t] + co);
#pragma unroll
      for (int t = 0; t < 2; ++t) bfr[0][t] = *(const bf16x8*)(Sc + boff[t] + co);
    }
#pragma unroll
    for (int s = 0; s < 4; ++s) {
      if (s < 3) {
        const int co = ((2 * (s + 1) + h) ^ fsw) << 4;
#pragma unroll
        for (int t = 0; t < 4; ++t) af[(s + 1) & 1][t] = *(const bf16x8*)(Sc + aoff[t] + co);
#pragma unroll
        for (int t = 0; t < 2; ++t) bfr[(s + 1) & 1][t] = *(const bf16x8*)(Sc + boff[t] + co);
      }
      if (more && s < 2) {
        dma16_saddr(An, loff[2 * s], ldn + (2 * s) * 1024); dma16_saddr(Bn, loff[2 * s], ldn + 32768 + (2 * s) * 1024);
        dma16_saddr(An, loff[2 * s + 1], ldn + (2 * s + 1) * 1024); dma16_saddr(Bn, loff[2 * s + 1], ldn + 32768 + (2 * s + 1) * 1024);
      }
      __builtin_amdgcn_sched_barrier(0);
      __builtin_amdgcn_s_setprio(1);
#pragma unroll
      for (int a = 0; a < 4; ++a)
#pragma unroll
        for (int b = 0; b < 2; ++b) acc[a][b] = __builtin_amdgcn_mfma_f32_32x32x16_bf16(af[s & 1][a], bfr[s & 1][b], acc[a][b], 0, 0, 0);
      __builtin_amdgcn_s_setprio(0);
      __builtin_amdgcn_sched_barrier(0);
    }
  }
}
DI void gemm_big_dump(const int tid_, const f32x16 (&acc)[4][2], int pass, char* lds) {
  const int lane = tid_ & 63, wave = tid_ >> 6;
  const int wm = wave >> 2, wn = wave & 3, r = lane & 31, h = lane >> 5;
  __syncthreads();
  if ((wn >> 1) == pass) {
    float* Cs = (float*)lds;
#pragma unroll
    for (int a = 0; a < 4; ++a)
#pragma unroll
      for (int b = 0; b < 2; ++b)
#pragma unroll
        for (int i = 0; i < 16; ++i) Cs[(wm * 128 + a * 32 + crow(i, h)) * 132 + (wn & 1) * 64 + b * 32 + r] = acc[a][b][i];
  }
  __syncthreads();
}

#define KM_TOTAL (NB * 6 * 16 * 64)
#define X1B(p) ((p).QKV + (size_t)8 * T_TOK * 128)
DI void epi_headnorm(const int tid_, const float* Cs, bf16_t* __restrict__ dst, size_t rows_total, int m0, int g0, const float* gain0, const float* gain1,
                     bf16_t* kmean = nullptr, float* red = nullptr, float qscale = 1.0f) {
  const int tid = tid_;
  float csum[8] = {0.f, 0.f, 0.f, 0.f, 0.f, 0.f, 0.f, 0.f};
#pragma unroll 1
  for (int it = 0; it < 8; ++it) {
    const int task = tid + NTHREADS * it;
    const int sub = task & 7, grp = (task >> 3) & 1, row = task >> 4;
    const float4 c0 = *(const float4*)(Cs + row * 132 + grp * 64 + sub * 8);
    const float4 c1 = *(const float4*)(Cs + row * 132 + grp * 64 + sub * 8 + 4);
    float v[8] = {c0.x, c0.y, c0.z, c0.w, c1.x, c1.y, c1.z, c1.w};
    const float* gain = grp ? gain1 : gain0;
    float ss = 0.f;
#pragma unroll
    for (int j = 0; j < 8; ++j) ss += v[j] * v[j];
    ss = sum8(ss);
    if (gain) {
      const float rinv = rsqrtf(ss * (1.0f / 64.0f) + 1e-6f) * qscale;
#pragma unroll
      for (int j = 0; j < 8; ++j) v[j] *= rinv * gain[sub * 8 + j];
    }
    *(uint4*)(dst + ((size_t)(g0 + grp) * rows_total + m0 + row) * 64 + sub * 8) =
        make_uint4(pack2(v[0], v[1]), pack2(v[2], v[3]), pack2(v[4], v[5]), pack2(v[6], v[7]));
    if (kmean) {
#pragma unroll
      for (int j = 0; j < 8; ++j) csum[j] += v[j];
    }
  }
  if (kmean) {
#pragma unroll
    for (int j = 0; j < 8; ++j) red[(tid >> 4) * 128 + (tid & 15) * 8 + j] = csum[j];
    __syncthreads();
    if (tid < 128) {
      float a = 0.f;
#pragma unroll 8
      for (int rgrp = 0; rgrp < 32; ++rgrp) a += red[rgrp * 128 + tid];
      const float av = a * (1.0f / 256.0f);
      const unsigned ph = pack2(av, 0.f) & 0xffffu;
      const unsigned pl = pack2(av - __uint_as_float(ph << 16), 0.f) & 0xffffu;
      kmean[(tid >> 6) * 1024 + (tid & 63)] = (bf16_t)ph;
      kmean[KM_TOTAL + (tid >> 6) * 1024 + (tid & 63)] = (bf16_t)pl;
    }
  }
}
DI const float* gain_for_group(const Params& p, int g) {
  const int kind = g / 6;
  switch (kind) {
    case 0: return p.qg_dil;
    case 1: return p.kg_dil;
    case 3: return p.qg_moba;
    case 4: return p.kg_moba;
    case 6: return p.qg_mem;
    default: return nullptr;
  }
}

DI bool xcd_tile_big(int bid, int nblk, int it, int n_tiles_n, int& mt, int& nt) {
  const int x = bid & 7, j = bid >> 3, nb = nblk >> 3;
  const int seq = it * nb + j;
  if (seq >= 32 * n_tiles_n) return false;
  const int per_group = 4 * n_tiles_n;
  const int mg = seq / per_group, rem = seq - mg * per_group;
  nt = rem >> 2; mt = x * 32 + mg * 4 + (rem & 3);
  return true;
}

DI void phase_proj(const int tid_, const Params& p, int bid, int nblk, char* lds) {
  int mt, nt;
  f32x16 acc[4][2];
  for (int it = 0; xcd_tile_big(bid, nblk, it, 10, mt, nt); ++it) {
    gemm_big(tid_, p.HN, p.WinT, DM, mt * 256, nt * 256, lds, acc);
#pragma unroll 1
    for (int pass = 0; pass < 2; ++pass) {
      gemm_big_dump(tid_, acc, pass, lds);
      const int g0 = nt * 4 + pass * 2;
      bf16_t* km = (g0 >= 24 && g0 < 30) ? (bf16_t*)p.KMEAN + ((size_t)((mt >> 4) * 6 + (g0 - 24)) * 16 + (mt & 15)) * 64 : nullptr;
      epi_headnorm(tid_, (const float*)lds, p.QKV, T_TOK, mt * 256, g0, gain_for_group(p, g0), gain_for_group(p, g0 + 1), km, (float*)(lds + RING_BYTES),
                   (g0 < 6 || (g0 >= 18 && g0 < 24) || g0 >= 36) ? 0.125f * 1.4426950408889634f : 1.0f);
    }
  }
  for (int t2 = bid; t2 < 16 * 2; t2 += nblk) {
    const int mt2 = t2 >> 1, nt2 = t2 & 1;
    gemm_big(tid_, p.MEMN, p.WmkvT, DM, mt2 * 256, nt2 * 256, lds, acc);
#pragma unroll 1
    for (int pass = 0; pass < 2; ++pass) {
      gemm_big_dump(tid_, acc, pass, lds);
      const float* gn = (nt2 == 0) ? p.kg_mem : nullptr;
      epi_headnorm(tid_, (const float*)lds, p.KVM, NB * MEMLEN, mt2 * 256, nt2 * 4 + pass * 2, gn, gn);
    }
  }
}

DI float alibi_slope(int i) { return exp2f(-8.0f * (float)(i + 1) / 12.0f); }

#define LOG2E 1.4426950408889634f
#define ATT_SCALE2 (0.125f * LOG2E)
#define MASKVAL (-3.0e38f)

struct AttnState { float m, l; f32x16 o[2]; };

template <bool BIAS>
DI void attn_tile64(const int tid_, const char* Kl, const char* Vl, const bf16x8 (&qf)[4], AttnState& st, float A, const float (&Bc)[2][16],
                    float dqh, int mode0, int mode1, bool colvalid, float lo, float hi) {
  const int lane = tid_ & 63, r = lane & 31, h = lane >> 5;
  f32x16 s0, s1;
#pragma unroll
  for (int i = 0; i < 16; ++i) { s0[i] = 0.f; s1[i] = 0.f; }
  const char* kp = Kl + r * 128;
  const int ksw = (r >> 1) & 7;
#pragma unroll
  for (int ks = 0; ks < 4; ++ks) {
    const bf16x8 k0 = *(const bf16x8*)(kp + (((2 * ks + h) ^ ksw) << 4));
    const bf16x8 k1 = *(const bf16x8*)(kp + 4096 + (((2 * ks + h) ^ ksw) << 4));
    s0 = __builtin_amdgcn_mfma_f32_32x32x16_bf16(k0, qf[ks], s0, 0, 0, 0);
    s1 = __builtin_amdgcn_mfma_f32_32x32x16_bf16(k1, qf[ks], s1, 0, 0, 0);
  }
  const f32x2 sc2 = {ATT_SCALE2, ATT_SCALE2};
#pragma unroll
  for (int j = 0; j < 8; ++j) {
    f32x2 a0 = {s0[2 * j], s0[2 * j + 1]}, a1 = {s1[2 * j], s1[2 * j + 1]};
    if (BIAS) {
      const f32x2 b0 = {Bc[0][2 * j], Bc[0][2 * j + 1]}, b1 = {Bc[1][2 * j], Bc[1][2 * j + 1]};
      a0 = __builtin_elementwise_fma(a0, sc2, b0); a1 = __builtin_elementwise_fma(a1, sc2, b1);
    } else { a0 = a0 * sc2; a1 = a1 * sc2; }
    s0[2 * j] = a0[0]; s0[2 * j + 1] = a0[1]; s1[2 * j] = a1[0]; s1[2 * j + 1] = a1[1];
  }
  if (BIAS && mode0 != 1) {
#pragma unroll
    for (int i = 0; i < 16; ++i) {
      const float delta = dqh - (float)((i & 3) + 8 * (i >> 2));
      s0[i] = (mode0 == 2 && delta >= lo && delta <= hi) ? s0[i] : MASKVAL;
    }
  }
  if (BIAS && mode1 != 1) {
#pragma unroll
    for (int i = 0; i < 16; ++i) {
      const float delta = dqh - (float)(32 + (i & 3) + 8 * (i >> 2));
      s1[i] = (mode1 == 2 && delta >= lo && delta <= hi) ? s1[i] : MASKVAL;
    }
  }
  float tmax = __builtin_fmaxf(s0[0], s1[0]);
#pragma unroll
  for (int i = 1; i < 16; ++i) tmax = __builtin_fmaxf(__builtin_fmaxf(tmax, s0[i]), s1[i]);
  tmax += A;
  tmax = colvalid ? tmax : MASKVAL;
  tmax = fmaxf(tmax, __shfl_xor(tmax, 32));
  const float mnew = fmaxf(st.m, tmax);
  const float alpha = __builtin_amdgcn_exp2f(st.m - mnew);
  st.m = mnew;
  const float dsub = colvalid ? mnew - A : 3.0e38f;
  const f32x2 nd2 = {-dsub, -dsub};
  f32x2 ps0 = {0.f, 0.f}, ps1 = {0.f, 0.f};
#pragma unroll
  for (int j = 0; j < 8; ++j) {
    f32x2 a0 = {s0[2 * j], s0[2 * j + 1]}, a1 = {s1[2 * j], s1[2 * j + 1]};
    a0 = a0 + nd2; a1 = a1 + nd2;
    a0[0] = __builtin_amdgcn_exp2f(a0[0]); a0[1] = __builtin_amdgcn_exp2f(a0[1]);
    a1[0] = __builtin_amdgcn_exp2f(a1[0]); a1[1] = __builtin_amdgcn_exp2f(a1[1]);
    ps0 = ps0 + a0; ps1 = ps1 + a1;
    s0[2 * j] = a0[0]; s0[2 * j + 1] = a0[1]; s1[2 * j] = a1[0]; s1[2 * j + 1] = a1[1];
  }
  ps0 = ps0 + ps1;
  st.l = st.l * alpha + (ps0[0] + ps0[1]);
  if (__ballot(alpha != 1.0f) != 0ull) {
#pragma unroll
    for (int i = 0; i < 16; ++i) { st.o[0][i] *= alpha; st.o[1][i] *= alpha; }
  }
  const int q4 = (lane & 15) >> 2, p4 = lane & 3, g = (lane >> 4) & 1;
#pragma unroll
  for (int s2 = 0; s2 < 4; ++s2) {
    u32x4 pk;
    if (s2 < 2) {
      pk[0] = pack2(s0[8 * s2 + 0], s0[8 * s2 + 1]); pk[1] = pack2(s0[8 * s2 + 2], s0[8 * s2 + 3]);
      pk[2] = pack2(s0[8 * s2 + 4], s0[8 * s2 + 5]); pk[3] = pack2(s0[8 * s2 + 6], s0[8 * s2 + 7]);
    } else {
      pk[0] = pack2(s1[8 * (s2 - 2) + 0], s1[8 * (s2 - 2) + 1]); pk[1] = pack2(s1[8 * (s2 - 2) + 2], s1[8 * (s2 - 2) + 3]);
      pk[2] = pack2(s1[8 * (s2 - 2) + 4], s1[8 * (s2 - 2) + 5]); pk[3] = pack2(s1[8 * (s2 - 2) + 6], s1[8 * (s2 - 2) + 7]);
    }
    const bf16x8 pf = __builtin_bit_cast(bf16x8, pk);
    const int row_lo = 16 * s2 + 4 * h + q4;
    const int row_hi = row_lo + 8;
    const int sw_lo = ((row_lo >> 1) & 1) << 6, sw_hi = ((row_hi >> 1) & 1) << 6;
#pragma unroll
    for (int dt = 0; dt < 2; ++dt) {
      const int cb = 64 * dt + 32 * g + 8 * p4;
      const s16x4 lo4 = __builtin_amdgcn_ds_read_tr16_b64_v4i16((LDSP s16x4*)(Vl + row_lo * 128 + (cb ^ sw_lo)));
      const s16x4 hi4 = __builtin_amdgcn_ds_read_tr16_b64_v4i16((LDSP s16x4*)(Vl + row_hi * 128 + (cb ^ sw_hi)));
      const bf16x8 vf = __builtin_shufflevector(lo4, hi4, 0, 1, 2, 3, 4, 5, 6, 7);
      st.o[dt] = __builtin_amdgcn_mfma_f32_32x32x16_bf16(vf, pf, st.o[dt], 0, 0, 0);
    }
  }
}

#define ATT_STAGE_BYTES 16384
#define ATT_NSTAGE 8
#define ATT_LA 6
DI void attn_tile_dma(const int tid_, const bf16_t*& kp, const bf16_t*& vp, long tstride, char* stg) {
  const int lane = tid_ & 63, w8 = tid_ >> 6;
  __builtin_amdgcn_global_load_lds((const unsigned*)kp, (LDSP unsigned*)(stg + w8 * 1024 + lane * 16), 16, 0, 0);
  __builtin_amdgcn_global_load_lds((const unsigned*)vp, (LDSP unsigned*)(stg + 8192 + w8 * 1024 + lane * 16), 16, 0, 0);
  kp += tstride; vp += tstride;
}

template <int TYPE>
DI void attn_item(const int tid_, const Params& p, char* lds, int b, int hd, int m, int c, int res) {
  const int tid = tid_, lane = tid & 63, w8 = tid >> 6, nh = w8 >> 2, w = w8 & 3, r = lane & 31, h = lane >> 5;
  const int n = 2 * m + nh;
  const size_t tb = (size_t)b * SEQ;
  const bf16_t *Q, *Kb, *Vb;
  int d = 1;
  float slope2 = 0.f;
  if (TYPE == 0) {
    Q = p.QKV + ((size_t)(36 + hd) * T_TOK + tb) * 64;
    Kb = p.KVM + ((size_t)hd * (NB * MEMLEN) + (size_t)b * MEMLEN) * 64;
    Vb = p.KVM + ((size_t)(4 + hd) * (NB * MEMLEN) + (size_t)b * MEMLEN) * 64;
  } else if (TYPE == 1) {
    Q = p.QKV + ((size_t)hd * T_TOK + tb) * 64;
    Kb = p.QKV + ((size_t)(6 + hd) * T_TOK + tb) * 64;
    Vb = p.QKV + ((size_t)(12 + hd) * T_TOK + tb) * 64;
    d = (c == 0) ? 1 : (c == 1 ? 4 : 16);
    slope2 = alibi_slope(2 * hd) * (float)d * LOG2E;
  } else {
    Q = p.QKV + ((size_t)(18 + hd) * T_TOK + tb) * 64;
    Kb = p.QKV + ((size_t)(24 + hd) * T_TOK + tb) * 64;
    Vb = p.QKV + ((size_t)(30 + hd) * T_TOK + tb) * 64;
    slope2 = alibi_slope(2 * hd + 1) * LOG2E;
  }
  int t_lo, t_hi;
  long krow0, kstride;
  if (TYPE == 0) { t_lo = 0; t_hi = 4; krow0 = 0; kstride = 1; }
  else if (TYPE == 1) { t_lo = (m == 0) ? 2 : 0; t_hi = 6; krow0 = (long)(128 * (2 * m - 1)) * d + res; kstride = d; }
  else { t_lo = 0; t_hi = 4 * m + 4; krow0 = 0; kstride = 1; }

  const bf16_t* kp;
  const bf16_t* vp;
  {
    const int row = 8 * w8 + (lane >> 3), pos = lane & 7;
    const long grow = krow0 + ((long)t_lo * 64 + row) * kstride;
    kp = Kb + grow * 64 + ((pos ^ ((row >> 1) & 7)) << 3);
    vp = Vb + grow * 64 + ((pos ^ (((row >> 1) & 1) << 2)) << 3);
  }
  const long tstride = 64 * kstride * 64;
  {
    const int npro = (t_hi - t_lo) < ATT_LA ? (t_hi - t_lo) : ATT_LA;
    for (int i = 0; i < npro; ++i) attn_tile_dma(tid_, kp, vp, tstride, lds + i * ATT_STAGE_BYTES);
  }
  const int qsub = 128 * n + 32 * w + r;
  const long qrow = (TYPE == 1) ? ((long)qsub * d + res) : (long)qsub;
  bf16x8 qf[4];
#pragma unroll
  for (int ks = 0; ks < 4; ++ks) qf[ks] = *(const bf16x8*)(Q + qrow * 64 + (2 * ks + h) * 8);

  unsigned selmask = 0;
  const int own = n >> 1;
  if (TYPE == 2 && own > 0) {
    float qv[32];
#pragma unroll
    for (int ks = 0; ks < 4; ++ks)
#pragma unroll
      for (int j = 0; j < 8; ++j) qv[ks * 8 + j] = bf2f((bf16_t)qf[ks][j]);
    const float* km = p.KMEAN + (size_t)(b * 6 + hd) * 16 * 64;
    float v0 = -3.4e38f, v1 = -3.4e38f, v2 = -3.4e38f;
    int i0 = 31, i1 = 31, i2 = 31;
    for (int j = 0; j < own; ++j) {
      float part = 0.f;
#pragma unroll
      for (int ks = 0; ks < 4; ++ks) {
        const float4 k0 = *(const float4*)(km + j * 64 + 16 * ks + 8 * h);
        const float4 k1 = *(const float4*)(km + j * 64 + 16 * ks + 8 * h + 4);
        part += qv[ks * 8 + 0] * k0.x + qv[ks * 8 + 1] * k0.y + qv[ks * 8 + 2] * k0.z + qv[ks * 8 + 3] * k0.w +
                qv[ks * 8 + 4] * k1.x + qv[ks * 8 + 5] * k1.y + qv[ks * 8 + 6] * k1.z + qv[ks * 8 + 7] * k1.w;
      }
      const float gte = part + __shfl_xor(part, 32);
      if (gte > v2) {
        if (gte > v1) {
          v2 = v1; i2 = i1;
          if (gte > v0) { v1 = v0; i1 = i0; v0 = gte; i0 = j; } else { v1 = gte; i1 = j; }
        } else { v2 = gte; i2 = j; }
      }
    }
    selmask = ((1u << i0) | (1u << i1) | (1u << i2)) & 0xffffu;
  }

  AttnState st;
  st.m = -1.0e30f; st.l = 0.f;
#pragma unroll
  for (int i = 0; i < 16; ++i) { st.o[0][i] = 0.f; st.o[1][i] = 0.f; }

  float Bc[2][16];
#pragma unroll
  for (int i = 0; i < 16; ++i) { Bc[0][i] = slope2 * (float)((i & 3) + 8 * (i >> 2)); Bc[1][i] = slope2 * (float)(32 + (i & 3) + 8 * (i >> 2)); }
  for (int t = t_lo; t < t_hi; ++t) {
    int ahead = t_hi - 1 - t;
    ahead = ahead > ATT_LA - 1 ? ATT_LA - 1 : ahead;
    switch (ahead) {
      case 5: asm volatile("s_waitcnt vmcnt(10) lgkmcnt(0)" ::: "memory"); break;
      case 4: asm volatile("s_waitcnt vmcnt(8) lgkmcnt(0)" ::: "memory"); break;
      case 3: asm volatile("s_waitcnt vmcnt(6) lgkmcnt(0)" ::: "memory"); break;
      case 2: asm volatile("s_waitcnt vmcnt(4) lgkmcnt(0)" ::: "memory"); break;
      case 1: asm volatile("s_waitcnt vmcnt(2) lgkmcnt(0)" ::: "memory"); break;
      default: asm volatile("s_waitcnt vmcnt(0) lgkmcnt(0)" ::: "memory"); break;
    }
    __builtin_amdgcn_s_barrier();
    if (t + ATT_LA < t_hi) attn_tile_dma(tid_, kp, vp, tstride, lds + ((t + ATT_LA - t_lo) & (ATT_NSTAGE - 1)) * ATT_STAGE_BYTES);
    const char* buf = lds + ((t - t_lo) & (ATT_NSTAGE - 1)) * ATT_STAGE_BYTES;
    int mode0 = 1, mode1 = 1;
    bool cv = true;
    float dq = 0.f, lo = 0.f, hi = 0.f;
    if (TYPE == 1) {
      const int ur0 = 2 * t - 4 * nh, ur1 = ur0 + 1;
      mode0 = (ur0 < w || ur0 > w + 4) ? 0 : ((ur0 == w || ur0 == w + 4) ? 2 : 1);
      mode1 = (ur1 < w || ur1 > w + 4) ? 0 : ((ur1 == w || ur1 == w + 4) ? 2 : 1);
      lo = 0.f; hi = 128.f;
      dq = (float)(qsub - (128 * (2 * m - 1) + 64 * t));
    } else if (TYPE == 2) {
      dq = (float)(qsub - 64 * t);
      if (t < 4 * m) { cv = (selmask >> (t >> 2)) & 1u; }
      else {
        const int uq = 4 * n + w;
        mode0 = (2 * t > uq) ? 0 : ((2 * t == uq) ? 2 : 1);
        mode1 = (2 * t + 1 > uq) ? 0 : ((2 * t + 1 == uq) ? 2 : 1);
        lo = 0.f; hi = 1.0e30f;
      }
    }
    if (mode0 == 0 && mode1 == 0) continue;
    const float dqh = dq - (float)(4 * h);
    attn_tile64<(TYPE != 0)>(tid_, buf, buf + 8192, qf, st, -slope2 * dqh, Bc, dqh, mode0, mode1, cv, lo, hi);
  }
  __syncthreads();

  const float ltot = st.l + __shfl_xor(st.l, 32);
  const float inv = 1.0f / ltot;
  bf16_t* dst;
  if (TYPE == 0) dst = p.HN + (tb + qsub) * DM + 768 + hd * 64;
  else if (TYPE == 2) dst = p.HN + (tb + qsub) * DM + 384 + hd * 64;
  else {
    const size_t tok = tb + (size_t)qrow;
    dst = p.DILO + ((size_t)c * T_TOK + tok) * 384 + hd * 64;
    if (h == 0) p.LSE2[((size_t)c * T_TOK + tok) * 6 + hd] = st.m + __builtin_amdgcn_logf(ltot);
  }
#pragma unroll
  for (int dt = 0; dt < 2; ++dt)
#pragma unroll
    for (int gq = 0; gq < 4; ++gq) {
      uint2 o;
      o.x = pack2(st.o[dt][4 * gq + 0] * inv, st.o[dt][4 * gq + 1] * inv);
      o.y = pack2(st.o[dt][4 * gq + 2] * inv, st.o[dt][4 * gq + 3] * inv);
      *(uint2*)(dst + 32 * dt + 8 * gq + 4 * h) = o;
    }
}

#define AH_SLOTB 8192
#define AH_LDS_K 0
#define AH_LDS_V (3 * AH_SLOTB)
#define AH_THR 8.0f
#define AH_SBAR() __builtin_amdgcn_sched_barrier(0)
#define AH_PIN(x) asm volatile("" : "+v"(x))
#define AH_MFMA(a, b, c) __builtin_amdgcn_mfma_f32_32x32x16_bf16(a, b, c, 0, 0, 0)
#define AH_WAIT_BAR(N) asm volatile("s_waitcnt vmcnt(" #N ") lgkmcnt(0)\n\ts_barrier" ::: "memory")
typedef __attribute__((address_space(3))) const char* ah_lds_cptr;
DI void ah_kload2(bf16x8* kf, ah_lds_cptr kp, int d0) {
  kf[2 * d0] = *(const __attribute__((address_space(3))) bf16x8*)(kp + d0 * 2048);
  kf[2 * d0 + 1] = *(const __attribute__((address_space(3))) bf16x8*)(kp + d0 * 2048 + 512);
}
DI s16x4 ah_vtr(ah_lds_cptr p) { return __builtin_amdgcn_ds_read_tr16_b64_v4i16((__attribute__((address_space(3))) s16x4*)p); }
#define AH_MX3(a, b, c) __builtin_fmaxf(__builtin_fmaxf((a), (b)), (c))
DI float ah_rowmax(const f32x16& p0, const f32x16& p1) {
  float a = AH_MX3(p0[0], p0[1], p1[0]), b = AH_MX3(p0[2], p0[3], p1[1]); a = AH_MX3(a, p1[2], p1[3]);
#pragma unroll
  for (int r = 4; r < 16; r += 4) { a = AH_MX3(a, p0[r], p0[r + 1]); b = AH_MX3(b, p0[r + 2], p0[r + 3]); a = AH_MX3(a, p1[r], p1[r + 1]); b = AH_MX3(b, p1[r + 2], p1[r + 3]); }
  const float m = __builtin_fmaxf(a, b);
  auto rr = __builtin_amdgcn_permlane32_swap(__float_as_uint(m), __float_as_uint(m), false, false);
  return __builtin_fmaxf(__uint_as_float(rr[0]), __uint_as_float(rr[1]));
}
DI void ah_cmask(f32x16& p0, f32x16& p1, int jb, int qrel, int hi) {
  const int kb = 64 * jb + 4 * hi;
#pragma unroll
  for (int r = 0; r < 16; ++r) { const int kv = kb + (r & 3) + 8 * (r >> 2); if (kv > qrel) p0[r] = -INFINITY; if (kv + 32 > qrel) p1[r] = -INFINITY; }
}

template <int TYPE>
DI void attn_unit_hi(const int tid_, const Params& p, char* lds, int b, int hd, int m) {
  const int tid = tid_, lane = tid & 63, r32 = lane & 31, hi = lane >> 5;
  const int wid = __builtin_amdgcn_readfirstlane(tid >> 6);
  const size_t tb = (size_t)b * SEQ;
  const bf16_t *Q, *Kb, *Vb;
  float slope2 = 0.f;
  if (TYPE == 0) {
    Q = p.QKV + ((size_t)(36 + hd) * T_TOK + tb) * 64;
    Kb = p.KVM + ((size_t)hd * (NB * MEMLEN) + (size_t)b * MEMLEN) * 64;
    Vb = p.KVM + ((size_t)(4 + hd) * (NB * MEMLEN) + (size_t)b * MEMLEN) * 64;
  } else {
    Q = p.QKV + ((size_t)(18 + hd) * T_TOK + tb) * 64;
    Kb = p.QKV + ((size_t)(24 + hd) * T_TOK + tb) * 64;
    Vb = p.QKV + ((size_t)(30 + hd) * T_TOK + tb) * 64;
    slope2 = alibi_slope(2 * hd + 1) * LOG2E;
  }
  const int q0 = 256 * m, NTT = (TYPE == 0) ? 4 : 4 * m + 4;
  int NT = NTT;
  if (TYPE == 2) {
    const float gq = wave_max(__builtin_fabsf(p.qg_moba[lane])), gk = wave_max(__builtin_fabsf(p.kg_moba[lane]));
    const float smax = 64.0f * gq * gk * ATT_SCALE2 * 1.02f;
    const float need = (146.0f + 2.0f * smax) / slope2 + 255.0f;
    const int nlive = (need < 65536.0f) ? (int)(need * (1.0f / 64.0f)) + 1 : 65536;
    const int nt2 = (nlive + 1) & ~1;
    NT = __builtin_amdgcn_readfirstlane(nt2 < NTT ? (nt2 < 4 ? 4 : nt2) : NTT);
  }
  const bf16_t* Qw = Q + (size_t)(q0 + wid * 32) * 64;
  const unsigned lds0 = (unsigned)(size_t)lds;
  const unsigned koff = (unsigned)((lane * 64 + wid * 8) * 2);
  const unsigned voff = (unsigned)(((16 * (wid & 3) + (lane >> 2)) * 64 + (wid >> 2) * 32 + (lane & 3) * 8) * 2);
  const unsigned kdst = lds0 + AH_LDS_K + wid * 1024, vdst = lds0 + AH_LDS_V + wid * 1024;
  const char* Kc = (const char*)Kb;
  const char* Vc = (const char*)Vb;
#define AH_TA(u) ((TYPE == 2) ? (NTT - 1 - (u)) : (u))
#define AH_DMA_K(t, slot) dma16_saddr(Kc + (size_t)AH_TA(t) * 8192, koff, kdst + (unsigned)(slot))
#define AH_DMA_V(t, slot) dma16_saddr(Vc + (size_t)AH_TA(t) * 8192, voff, vdst + (unsigned)(slot))
  const ah_lds_cptr vp0 = (ah_lds_cptr)lds + AH_LDS_V + ((lane >> 4) & 1) * 32 + (lane & 3) * 8 + (4 * hi + ((lane & 15) >> 2)) * 64;
  const ah_lds_cptr kp0 = (ah_lds_cptr)lds + AH_LDS_K + hi * 1024 + r32 * 16;
  AH_DMA_K(0, 0); AH_DMA_V(0, 0); AH_DMA_K(1, AH_SLOTB);
  bf16x8 qr[4];
#pragma unroll
  for (int d0 = 0; d0 < 4; ++d0) qr[d0] = *(const bf16x8*)(Qw + (size_t)r32 * 64 + d0 * 16 + hi * 8);
  unsigned selmask = 0;
  if (TYPE == 2 && m > 0) {
    const bf16_t* kmh = (const bf16_t*)p.KMEAN + (size_t)(b * 6 + hd) * 16 * 64 + (r32 & 15) * 64 + 8 * hi;
    bf16x8 ah[4], al[4];
#pragma unroll
    for (int ks = 0; ks < 4; ++ks) { ah[ks] = *(const bf16x8*)(kmh + 16 * ks); al[ks] = *(const bf16x8*)(kmh + KM_TOTAL + 16 * ks); }
    f32x16 g;
#pragma unroll
    for (int i = 0; i < 16; ++i) g[i] = 0.f;
#pragma unroll
    for (int ks = 0; ks < 4; ++ks) { g = AH_MFMA(ah[ks], qr[ks], g); g = AH_MFMA(al[ks], qr[ks], g); }
    float gv[16];
#pragma unroll
    for (int i = 0; i < 8; ++i) {
      auto rr = __builtin_amdgcn_permlane32_swap(__float_as_uint(g[i]), __float_as_uint(g[i]), false, false);
      gv[(i & 3) + 8 * (i >> 2)] = __uint_as_float(rr[0]);
      gv[(i & 3) + 8 * (i >> 2) + 4] = __uint_as_float(rr[1]);
    }
    float v0 = -3.4e38f, v1 = -3.4e38f, v2 = -3.4e38f;
    int i0 = 31, i1 = 31, i2 = 31;
#pragma unroll
    for (int j = 0; j < 16; ++j) {
      const float gte = gv[j];
      if (j < m && gte > v2) {
        if (gte > v1) {
          v2 = v1; i2 = i1;
          if (gte > v0) { v1 = v0; i1 = i0; v0 = gte; i0 = j; } else { v1 = gte; i1 = j; }
        } else { v2 = gte; i2 = j; }
      }
    }
    selmask = ((1u << i0) | (1u << i1) | (1u << i2)) & 0xffffu;
  }
  float mhat = 0.f, l_reg = 0.f, fres = 1.f;
  f32x16 o[2];
#pragma unroll
  for (int i = 0; i < 16; ++i) { o[0][i] = 0.f; o[1][i] = 0.f; }
  f32x16 zero16;
#pragma unroll
  for (int i = 0; i < 16; ++i) zero16[i] = 0.f;
  if (TYPE == 0) AH_PIN(zero16);
  const int qrel = wid * 32 + r32;
  const float qposh = (float)(q0 + qrel - 4 * hi);
  bool resc = false;
  f32x16 pA0, pA1, pB0, pB1;
  bf16x8 kf[8];
  s16x4 vlo[8], vhi[8];
  u32x4 pw0, pw1, pw2, pw3;
  int sl_prev = 0, sl_cur = 0, sl_next = AH_SLOTB;
#define AH_ROT() do { sl_prev = sl_cur; sl_cur = sl_next; sl_next = (sl_next == 2 * AH_SLOTB) ? 0 : sl_next + AH_SLOTB; } while (0)
#define AH_INIT(C0, C1, u, ref)                                                                                     \
  do {                                                                                                              \
    if (TYPE == 2) {                                                                                                \
      const int ta_ = AH_TA(u);                                                                                     \
      const bool cv_ = (ta_ >= 4 * m) || ((selmask >> (ta_ >> 2)) & 1u);                                            \
      const float s_ = cv_ ? (-slope2 * (qposh - (float)(64 * ta_)) - (ref)) : -1.0e30f;                            \
      _Pragma("unroll") for (int i_ = 0; i_ < 16; ++i_) {                                                           \
        C0[i_] = __builtin_fmaf(slope2, (float)((i_ & 3) + 8 * (i_ >> 2)), s_);                                     \
        C1[i_] = __builtin_fmaf(slope2, (float)(32 + (i_ & 3) + 8 * (i_ >> 2)), s_);                                \
      }                                                                                                             \
    }                                                                                                               \
  } while (0)
#define AH_CIN(C) ((TYPE == 2) ? (C) : zero16)
#define AH_EX(v) ((TYPE == 2) ? __builtin_amdgcn_exp2f(v) : __builtin_amdgcn_exp2f((v) + nmh))
#define AH_RESC() do { if (resc) { _Pragma("unroll") for (int r_ = 0; r_ < 16; ++r_) { o[0][r_] *= fres; o[1][r_] *= fres; } } } while (0)
  AH_DMA_K(2, 2 * AH_SLOTB);
  AH_WAIT_BAR(3);
#pragma unroll
  for (int d0 = 0; d0 < 4; ++d0) ah_kload2(kf, kp0, d0);
  AH_INIT(pA0, pA1, 0, 0.f);
  pA0 = AH_MFMA(kf[0], qr[0], AH_CIN(pA0)); pA1 = AH_MFMA(kf[1], qr[0], AH_CIN(pA1)); pA0 = AH_MFMA(kf[2], qr[1], pA0); pA1 = AH_MFMA(kf[3], qr[1], pA1);
  pA0 = AH_MFMA(kf[4], qr[2], pA0); pA1 = AH_MFMA(kf[5], qr[2], pA1); pA0 = AH_MFMA(kf[6], qr[3], pA0); pA1 = AH_MFMA(kf[7], qr[3], pA1);
  if (TYPE == 2) ah_cmask(pA0, pA1, 3, qrel, hi);
  {
    const float rm = ah_rowmax(pA0, pA1);
    mhat = (TYPE == 2) ? __builtin_fmaxf(rm, -1000.0f) : rm;
    const float nm0 = -mhat;
#pragma unroll
    for (int r = 0; r < 16; ++r) { pA0[r] = __builtin_amdgcn_exp2f(pA0[r] + nm0); pA1[r] = __builtin_amdgcn_exp2f(pA1[r] + nm0); }
  }
  AH_WAIT_BAR(0);
  AH_DMA_K(3, 0); AH_DMA_V(1, AH_SLOTB); AH_ROT();
#pragma unroll
  for (int d0 = 0; d0 < 4; ++d0) ah_kload2(kf, kp0 + sl_cur, d0);
  AH_WAIT_BAR(2);
#define AH_PKW(P, i) pack2(P[i], P[i + 1])
#define AH_PAF(k) __builtin_bit_cast(bf16x8, pw##k)
#define AH_VFR(i) (bf16x8){vlo[i][0], vlo[i][1], vlo[i][2], vlo[i][3], vhi[i][0], vhi[i][1], vhi[i][2], vhi[i][3]}
#define AH_VRD(i) do { vlo[i] = ah_vtr(vp_ + (((i) >> 2) * 4096 + ((i) & 3) * 1024)); vhi[i] = ah_vtr(vp_ + (((i) >> 2) * 4096 + ((i) & 3) * 1024 + 512)); } while (0)
#define AH_KRD(G, d0) do { if (G) { ah_kload2(kf, kp0 + sl_next, d0); AH_SBAR(); } } while (0)
#define AH_GAPA(MF, a0, a1, a2, a3, W0, W1, PW) do { MF; sacc += a0; sacc += a1; sacc += a2; sacc += a3; W0; W1; AH_PIN(PW); AH_PIN(sacc); AH_SBAR(); } while (0)
#define AH_GAPB(MF, X, i) do { MF; X[i] = AH_EX(X[i]); X[i + 1] = AH_EX(X[i + 1]); X[i + 2] = AH_EX(X[i + 2]); X[i + 3] = AH_EX(X[i + 3]); AH_PIN(X); AH_SBAR(); } while (0)
#define AH_STEP(C0, C1, P0, P1, t, MASK, GK, GV, GL) do { AH_SBAR(); \
    AH_INIT(C0, C1, (t), mhat); \
    const ah_lds_cptr vp_ = vp0 + sl_prev; \
    AH_VRD(0); AH_SBAR(); float sacc = P0[0] + P0[1]; \
                       AH_GAPA(C0 = AH_MFMA(kf[0], qr[0], AH_CIN(C0)), P0[2], P0[3], P0[4], P0[5],     pw0[0] = AH_PKW(P0, 0),  pw0[1] = AH_PKW(P0, 2),  pw0); \
    AH_VRD(4); AH_SBAR(); AH_GAPA(C1 = AH_MFMA(kf[1], qr[0], AH_CIN(C1)), P0[6], P0[7], P0[8], P0[9],     pw0[2] = AH_PKW(P0, 4),  pw0[3] = AH_PKW(P0, 6),  pw0); \
    AH_VRD(1); AH_SBAR(); AH_GAPA(C0 = AH_MFMA(kf[2], qr[1], C0),    P0[10], P0[11], P0[12], P0[13], pw1[0] = AH_PKW(P0, 8),  pw1[1] = AH_PKW(P0, 10), pw1); \
    AH_VRD(5); AH_SBAR(); AH_GAPA(C1 = AH_MFMA(kf[3], qr[1], C1),    P0[14], P0[15], P1[0], P1[1],   pw1[2] = AH_PKW(P0, 12), pw1[3] = AH_PKW(P0, 14), pw1); \
    AH_VRD(2); AH_SBAR(); AH_GAPA(C0 = AH_MFMA(kf[4], qr[2], C0),    P1[2], P1[3], P1[4], P1[5],     pw2[0] = AH_PKW(P1, 0),  pw2[1] = AH_PKW(P1, 2),  pw2); \
    AH_VRD(6); AH_SBAR(); AH_GAPA(C1 = AH_MFMA(kf[5], qr[2], C1),    P1[6], P1[7], P1[8], P1[9],     pw2[2] = AH_PKW(P1, 4),  pw2[3] = AH_PKW(P1, 6),  pw2); \
    AH_VRD(3); AH_SBAR(); AH_GAPA(C0 = AH_MFMA(kf[6], qr[3], C0),    P1[10], P1[11], P1[12], P1[13], pw3[0] = AH_PKW(P1, 8),  pw3[1] = AH_PKW(P1, 10), pw3); \
    AH_VRD(7); AH_SBAR(); AH_GAPA(C1 = AH_MFMA(kf[7], qr[3], C1),    P1[14], P1[15], 0.f, 0.f,       pw3[2] = AH_PKW(P1, 12), pw3[3] = AH_PKW(P1, 14), pw3); \
    l_reg += sacc; \
    if (GK) AH_DMA_K((t) + 3, sl_cur); if (GV) AH_DMA_V((t) + 1, sl_next); \
    if (MASK) ah_cmask(C0, C1, 3 - (t), qrel, hi); \
    { const float rm = (TYPE == 2) ? ah_rowmax(C0, C1) : ah_rowmax(C0, C1) - mhat; resc = false;        \
      if (__builtin_expect(__any(rm > AH_THR), 0)) { const float dl = __builtin_fmaxf(rm, 0.f); mhat += dl;        \
          fres = __builtin_amdgcn_exp2f(-dl); l_reg *= fres; resc = true; \
          if (TYPE == 2) { _Pragma("unroll") for (int r_ = 0; r_ < 16; ++r_) { C0[r_] -= dl; C1[r_] -= dl; } } } } \
    const float nmh = -mhat; (void)nmh; AH_SBAR(); \
    AH_GAPB(o[0] = AH_MFMA(AH_VFR(0), AH_PAF(0), o[0]), C0, 0);              AH_GAPB(o[1] = AH_MFMA(AH_VFR(4), AH_PAF(0), o[1]), C0, 4); \
    AH_KRD(GL, 0); AH_GAPB(o[0] = AH_MFMA(AH_VFR(1), AH_PAF(1), o[0]), C0, 8);  AH_KRD(GL, 1); AH_GAPB(o[1] = AH_MFMA(AH_VFR(5), AH_PAF(1), o[1]), C0, 12); \
    AH_KRD(GL, 2); AH_GAPB(o[0] = AH_MFMA(AH_VFR(2), AH_PAF(2), o[0]), C1, 0);  AH_KRD(GL, 3); AH_GAPB(o[1] = AH_MFMA(AH_VFR(6), AH_PAF(2), o[1]), C1, 4); \
    AH_GAPB(o[0] = AH_MFMA(AH_VFR(3), AH_PAF(3), o[0]), C1, 8);              AH_GAPB(o[1] = AH_MFMA(AH_VFR(7), AH_PAF(3), o[1]), C1, 12); \
  } while (0)
#define AH_ENDW(tt) do { if ((tt) + 3 < NT) { AH_WAIT_BAR(2); } else if ((tt) + 2 < NT) { AH_WAIT_BAR(1); } else { AH_WAIT_BAR(0); } } while (0)
#define AH_PEELED_PAIR() do { \
    AH_STEP(pB0, pB1, pA0, pA1, t, (TYPE == 2 && t < 4), (t + 3 < NT), (t + 1 < NT), (t + 1 < NT));             AH_ENDW(t);     AH_RESC(); AH_ROT(); \
    AH_STEP(pA0, pA1, pB0, pB1, t + 1, (TYPE == 2 && t + 1 < 4), (t + 4 < NT), (t + 2 < NT), (t + 2 < NT));     AH_ENDW(t + 1); AH_RESC(); AH_ROT(); } while (0)
  int t = 1;
  if (TYPE == 2) { for (; t < 5 && t + 1 < NT; t += 2) AH_PEELED_PAIR(); }
  for (; t + 5 < NT; t += 2) {
    AH_STEP(pB0, pB1, pA0, pA1, t, false, true, true, true);     AH_WAIT_BAR(2); AH_RESC(); AH_ROT();
    AH_STEP(pA0, pA1, pB0, pB1, t + 1, false, true, true, true); AH_WAIT_BAR(2); AH_RESC(); AH_ROT();
  }
  for (; t + 1 < NT; t += 2) AH_PEELED_PAIR();
  AH_STEP(pB0, pB1, pA0, pA1, NT - 1, (TYPE == 2 && NT == 4), false, false, false); AH_RESC();
  {
    float sacc = pB0[0] + pB0[1];
#pragma unroll
    for (int r = 2; r < 16; ++r) sacc += pB0[r];
#pragma unroll
    for (int r = 0; r < 16; ++r) sacc += pB1[r];
    l_reg += sacc;
    pw0 = (u32x4){AH_PKW(pB0, 0), AH_PKW(pB0, 2), AH_PKW(pB0, 4), AH_PKW(pB0, 6)}; pw1 = (u32x4){AH_PKW(pB0, 8), AH_PKW(pB0, 10), AH_PKW(pB0, 12), AH_PKW(pB0, 14)};
    pw2 = (u32x4){AH_PKW(pB1, 0), AH_PKW(pB1, 2), AH_PKW(pB1, 4), AH_PKW(pB1, 6)}; pw3 = (u32x4){AH_PKW(pB1, 8), AH_PKW(pB1, 10), AH_PKW(pB1, 12), AH_PKW(pB1, 14)};
    const ah_lds_cptr vp_ = vp0 + sl_cur;
#pragma unroll
    for (int i = 0; i < 8; ++i) AH_VRD(i);
    o[0] = AH_MFMA(AH_VFR(0), AH_PAF(0), o[0]); o[1] = AH_MFMA(AH_VFR(4), AH_PAF(0), o[1]); o[0] = AH_MFMA(AH_VFR(1), AH_PAF(1), o[0]); o[1] = AH_MFMA(AH_VFR(5), AH_PAF(1), o[1]);
    o[0] = AH_MFMA(AH_VFR(2), AH_PAF(2), o[0]); o[1] = AH_MFMA(AH_VFR(6), AH_PAF(2), o[1]); o[0] = AH_MFMA(AH_VFR(3), AH_PAF(3), o[0]); o[1] = AH_MFMA(AH_VFR(7), AH_PAF(3), o[1]);
  }
  const float ltot = l_reg + __shfl_xor(l_reg, 32);
  const float inv = 1.0f / ltot;
  bf16_t* dst = p.HN + (tb + q0 + qrel) * DM + ((TYPE == 0) ? 768 : 384) + hd * 64;
#pragma unroll
  for (int dt = 0; dt < 2; ++dt)
#pragma unroll
    for (int gq = 0; gq < 4; ++gq) {
      uint2 ov;
      ov.x = pack2(o[dt][4 * gq + 0] * inv, o[dt][4 * gq + 1] * inv);
      ov.y = pack2(o[dt][4 * gq + 2] * inv, o[dt][4 * gq + 3] * inv);
      *(uint2*)(dst + 32 * dt + 8 * gq + 4 * hi) = ov;
    }
  asm volatile("s_waitcnt lgkmcnt(0)\n\ts_barrier" ::: "memory");
#undef AH_DMA_K
#undef AH_TA
#undef AH_DMA_V
#undef AH_ROT
#undef AH_INIT
#undef AH_CIN
#undef AH_EX
#undef AH_RESC
#undef AH_PKW
#undef AH_PAF
#undef AH_VFR
#undef AH_VRD
#undef AH_KRD
#undef AH_GAPA
#undef AH_GAPB
#undef AH_STEP
#undef AH_ENDW
#undef AH_PEELED_PAIR
}

#define AD_KB 0
#define AD_VB 49152
template <int KCH2>
DI void ad_kload2(bf16x8* kf, ah_lds_cptr kp, int d0) {
  kf[2 * d0] = *(const __attribute__((address_space(3))) bf16x8*)(kp + d0 * KCH2);
  kf[2 * d0 + 1] = *(const __attribute__((address_space(3))) bf16x8*)(kp + d0 * KCH2 + 512);
}
DI void ad_lmask(f32x16& c, int klo_h, int off) {
#pragma unroll
  for (int r = 0; r < 16; ++r) if (off + (r & 3) + 8 * (r >> 2) < klo_h) c[r] = -INFINITY;
}
DI void ad_umask(f32x16& c, int khi_h, int off) {
#pragma unroll
  for (int r = 0; r < 16; ++r) if (off + (r & 3) + 8 * (r >> 2) > khi_h) c[r] = -INFINITY;
}
DI float ad_rowmax16(const f32x16& p0) {
  float a = AH_MX3(p0[0], p0[1], p0[2]), b = AH_MX3(p0[3], p0[4], p0[5]);
  a = AH_MX3(a, p0[6], p0[7]); b = AH_MX3(b, p0[8], p0[9]); a = AH_MX3(a, p0[10], p0[11]); b = AH_MX3(b, p0[12], p0[13]); a = AH_MX3(a, p0[14], p0[15]);
  const float m = __builtin_fmaxf(a, b);
  auto rr = __builtin_amdgcn_permlane32_swap(__float_as_uint(m), __float_as_uint(m), false, false);
  return __builtin_fmaxf(__uint_as_float(rr[0]), __uint_as_float(rr[1]));
}

DI void attn_unit_dil(const int tid_, const Params& p, char* lds, int b, int hd, int m, int c, int res) {
  const int tid = tid_, lane = tid & 63, r32 = lane & 31, hi = lane >> 5;
  const int wid = __builtin_amdgcn_readfirstlane(tid >> 6);
  const size_t tb = (size_t)b * SEQ;
  const int d = (c == 0) ? 1 : (c == 1 ? 4 : 16);
  const bf16_t* Q = p.QKV + ((size_t)hd * T_TOK + tb) * 64;
  const char* Kc = (const char*)(p.QKV + ((size_t)(6 + hd) * T_TOK + tb) * 64);
  const char* Vc = (const char*)(p.QKV + ((size_t)(12 + hd) * T_TOK + tb) * 64);
  const float slope2 = alibi_slope(2 * hd) * (float)d * LOG2E;
  constexpr int AD_KCH2 = 12288, AD_VDH = 24576;
  const unsigned lds0 = (unsigned)(size_t)lds;
  {
    const unsigned koff = (unsigned)(lane * d * 128 + wid * 16);
    const unsigned voff = (unsigned)((16 * (wid & 3) + (lane >> 2)) * d * 128 + (wid >> 2) * 64 + (lane & 3) * 16);
    const unsigned kdst = lds0 + AD_KB + wid * 6144, vdst = lds0 + AD_VB + (wid >> 2) * 24576 + (wid & 3) * 1024;
#pragma unroll
    for (int i = 0; i < 6; ++i) {
      const int ie = (m == 0 && i < 2) ? 2 : i;
      const size_t rowb = ((size_t)((256 * m - 128 + 64 * ie) * d + res)) * 128;
      dma16_saddr(Kc + rowb, koff, kdst + i * 1024);
      dma16_saddr(Vc + rowb, voff, vdst + i * 4096);
    }
  }
  const int qsub = 256 * m + wid * 32 + r32;
  const size_t tok = tb + (size_t)qsub * d + res;
  bf16x8 qr[4];
#pragma unroll
  for (int d0 = 0; d0 < 4; ++d0) qr[d0] = *(const bf16x8*)(Q + ((size_t)qsub * d + res) * 64 + d0 * 16 + hi * 8);
  const int lb = (m == 0 && wid < 4) ? 128 - 32 * wid : 0;
  const ah_lds_cptr kp0 = (ah_lds_cptr)lds + AD_KB + hi * 6144 + (wid * 32 + r32) * 16;
  const ah_lds_cptr vp0 = (ah_lds_cptr)lds + AD_VB + ((lane >> 4) & 1) * 32 + (lane & 3) * 8 + (wid * 32 + 4 * hi + ((lane & 15) >> 2)) * 64;
  float mhat = 0.f, l_reg = 0.f, fres = 1.f;
  f32x16 o[2];
#pragma unroll
  for (int i = 0; i < 16; ++i) { o[0][i] = 0.f; o[1][i] = 0.f; }
  const float qposh = (float)(128 + r32 - 4 * hi);
  bool resc = false;
  f32x16 pA0, pA1, pB0, pB1;
  bf16x8 kf[8];
  s16x4 vlo[8], vhi[8];
  u32x4 pw0, pw1, pw2, pw3;
#define AD_INIT(C, u, koffs, ref) do { const float s_ = -slope2 * (qposh - (float)(64 * (u) + (koffs))) - (ref); \
    _Pragma("unroll") for (int i_ = 0; i_ < 16; ++i_) C[i_] = __builtin_fmaf(slope2, (float)((i_ & 3) + 8 * (i_ >> 2)), s_); } while (0)
#define AD_RESC() do { if (resc) { _Pragma("unroll") for (int r_ = 0; r_ < 16; ++r_) { o[0][r_] *= fres; o[1][r_] *= fres; } } } while (0)
#define AD_PKW(P, i) pack2(P[i], P[i + 1])
#define AD_PAF(k) __builtin_bit_cast(bf16x8, pw##k)
#define AD_VFR(i) (bf16x8){vlo[i][0], vlo[i][1], vlo[i][2], vlo[i][3], vhi[i][0], vhi[i][1], vhi[i][2], vhi[i][3]}
#define AD_VRD(i) do { vlo[i] = ah_vtr(vp_ + (((i) >> 2) * AD_VDH + ((i) & 3) * 1024)); vhi[i] = ah_vtr(vp_ + (((i) >> 2) * AD_VDH + ((i) & 3) * 1024 + 512)); } while (0)
#define AD_KRD(G, u, d0) do { if (G) { ad_kload2<AD_KCH2>(kf, kp0 + ((u) + 1) * 1024, d0); AH_SBAR(); } } while (0)
#define AD_GAPA(MF, a0, a1, a2, a3, W0, W1, PW) do { MF; sacc += a0; sacc += a1; sacc += a2; sacc += a3; W0; W1; AH_PIN(PW); AH_PIN(sacc); AH_SBAR(); } while (0)
#define AD_GAPB(MF, EXPS, X, i) do { MF; if (EXPS) { X[i] = __builtin_amdgcn_exp2f(X[i]); X[i + 1] = __builtin_amdgcn_exp2f(X[i + 1]); X[i + 2] = __builtin_amdgcn_exp2f(X[i + 2]); X[i + 3] = __builtin_amdgcn_exp2f(X[i + 3]); AH_PIN(X); } AH_SBAR(); } while (0)
#define AD_MF(G, x) do { if (G) { x; } } while (0)
#define AD_STEP(C0, C1, P0, P1, u, HALF, GL) do { AH_SBAR(); \
    AD_INIT(C0, (u), 0, mhat); if (!(HALF)) AD_INIT(C1, (u), 32, mhat); \
    const ah_lds_cptr vp_ = vp0 + ((u) - 1) * 4096; \
    AD_VRD(0); AH_SBAR(); float sacc = P0[0] + P0[1]; \
                          AD_GAPA(C0 = AH_MFMA(kf[0], qr[0], C0), P0[2], P0[3], P0[4], P0[5],     pw0[0] = AD_PKW(P0, 0),  pw0[1] = AD_PKW(P0, 2),  pw0); \
    AD_VRD(4); AH_SBAR(); AD_GAPA(AD_MF(!(HALF), C1 = AH_MFMA(kf[1], qr[0], C1)), P0[6], P0[7], P0[8], P0[9],     pw0[2] = AD_PKW(P0, 4),  pw0[3] = AD_PKW(P0, 6),  pw0); \
    AD_VRD(1); AH_SBAR(); AD_GAPA(C0 = AH_MFMA(kf[2], qr[1], C0),    P0[10], P0[11], P0[12], P0[13], pw1[0] = AD_PKW(P0, 8),  pw1[1] = AD_PKW(P0, 10), pw1); \
    AD_VRD(5); AH_SBAR(); AD_GAPA(AD_MF(!(HALF), C1 = AH_MFMA(kf[3], qr[1], C1)),    P0[14], P0[15], P1[0], P1[1],   pw1[2] = AD_PKW(P0, 12), pw1[3] = AD_PKW(P0, 14), pw1); \
    AD_VRD(2); AH_SBAR(); AD_GAPA(C0 = AH_MFMA(kf[4], qr[2], C0),    P1[2], P1[3], P1[4], P1[5],     pw2[0] = AD_PKW(P1, 0),  pw2[1] = AD_PKW(P1, 2),  pw2); \
    AD_VRD(6); AH_SBAR(); AD_GAPA(AD_MF(!(HALF), C1 = AH_MFMA(kf[5], qr[2], C1)),    P1[6], P1[7], P1[8], P1[9],     pw2[2] = AD_PKW(P1, 4),  pw2[3] = AD_PKW(P1, 6),  pw2); \
    AD_VRD(3); AH_SBAR(); AD_GAPA(C0 = AH_MFMA(kf[6], qr[3], C0),    P1[10], P1[11], P1[12], P1[13], pw3[0] = AD_PKW(P1, 8),  pw3[1] = AD_PKW(P1, 10), pw3); \
    AD_VRD(7); AH_SBAR(); AD_GAPA(AD_MF(!(HALF), C1 = AH_MFMA(kf[7], qr[3], C1)),    P1[14], P1[15], 0.f, 0.f,       pw3[2] = AD_PKW(P1, 12), pw3[3] = AD_PKW(P1, 14), pw3); \
    l_reg += sacc; \
    if (HALF) ad_umask(C0, r32 - 4 * hi, 0); \
    else if (lb > 64) { ad_lmask(C0, lb - 64 - 4 * hi, 0); ad_lmask(C1, lb - 64 - 4 * hi, 32); } \
    { const float rm = (HALF) ? ad_rowmax16(C0) : ah_rowmax(C0, C1); resc = false; \
      if (__builtin_expect(__any(rm > AH_THR), 0)) { const float dl = __builtin_fmaxf(rm, 0.f); mhat += dl; \
          fres = __builtin_amdgcn_exp2f(-dl); l_reg *= fres; resc = true; \
          _Pragma("unroll") for (int r_ = 0; r_ < 16; ++r_) { C0[r_] -= dl; if (!(HALF)) C1[r_] -= dl; } } } \
    AH_SBAR(); \
    AD_GAPB(o[0] = AH_MFMA(AD_VFR(0), AD_PAF(0), o[0]), true, C0, 0);                      AD_GAPB(o[1] = AH_MFMA(AD_VFR(4), AD_PAF(0), o[1]), true, C0, 4); \
    AD_KRD(GL, u, 0); AD_GAPB(o[0] = AH_MFMA(AD_VFR(1), AD_PAF(1), o[0]), true, C0, 8);  AD_KRD(GL, u, 1); AD_GAPB(o[1] = AH_MFMA(AD_VFR(5), AD_PAF(1), o[1]), true, C0, 12); \
    AD_KRD(GL, u, 2); AD_GAPB(o[0] = AH_MFMA(AD_VFR(2), AD_PAF(2), o[0]), !(HALF), C1, 0);  AD_KRD(GL, u, 3); AD_GAPB(o[1] = AH_MFMA(AD_VFR(6), AD_PAF(2), o[1]), !(HALF), C1, 4); \
    AD_GAPB(o[0] = AH_MFMA(AD_VFR(3), AD_PAF(3), o[0]), !(HALF), C1, 8);                   AD_GAPB(o[1] = AH_MFMA(AD_VFR(7), AD_PAF(3), o[1]), !(HALF), C1, 12); \
  } while (0)
  asm volatile("s_waitcnt vmcnt(0) lgkmcnt(0)\n\ts_barrier" ::: "memory");
#pragma unroll
  for (int d0 = 0; d0 < 4; ++d0) ad_kload2<AD_KCH2>(kf, kp0, d0);
  AD_INIT(pA0, 0, 0, 0.f); AD_INIT(pA1, 0, 32, 0.f);
  pA0 = AH_MFMA(kf[0], qr[0], pA0); pA1 = AH_MFMA(kf[1], qr[0], pA1); pA0 = AH_MFMA(kf[2], qr[1], pA0); pA1 = AH_MFMA(kf[3], qr[1], pA1);
  pA0 = AH_MFMA(kf[4], qr[2], pA0); pA1 = AH_MFMA(kf[5], qr[2], pA1); pA0 = AH_MFMA(kf[6], qr[3], pA0); pA1 = AH_MFMA(kf[7], qr[3], pA1);
  {
    const int klo = (r32 > lb ? r32 : lb) - 4 * hi;
    ad_lmask(pA0, klo, 0);
    if (lb > 32) ad_lmask(pA1, klo, 32);
    const float rm = ah_rowmax(pA0, pA1);
    mhat = __builtin_fmaxf(rm, -1000.0f);
    const float nm0 = -mhat;
#pragma unroll
    for (int r = 0; r < 16; ++r) { pA0[r] = __builtin_amdgcn_exp2f(pA0[r] + nm0); pA1[r] = __builtin_amdgcn_exp2f(pA1[r] + nm0); }
  }
#pragma unroll
  for (int d0 = 0; d0 < 4; ++d0) ad_kload2<AD_KCH2>(kf, kp0 + 1024, d0);
  AD_STEP(pB0, pB1, pA0, pA1, 1, false, true); AD_RESC();
  AD_STEP(pA0, pA1, pB0, pB1, 2, true, false);  AD_RESC();
  {
    float sacc = pA0[0] + pA0[1];
#pragma unroll
    for (int r = 2; r < 16; ++r) sacc += pA0[r];
    l_reg += sacc;
    pw0 = (u32x4){AD_PKW(pA0, 0), AD_PKW(pA0, 2), AD_PKW(pA0, 4), AD_PKW(pA0, 6)}; pw1 = (u32x4){AD_PKW(pA0, 8), AD_PKW(pA0, 10), AD_PKW(pA0, 12), AD_PKW(pA0, 14)};
    const ah_lds_cptr vp_ = vp0 + 2 * 4096;
    AD_VRD(0); AD_VRD(4); AD_VRD(1); AD_VRD(5);
    o[0] = AH_MFMA(AD_VFR(0), AD_PAF(0), o[0]); o[1] = AH_MFMA(AD_VFR(4), AD_PAF(0), o[1]); o[0] = AH_MFMA(AD_VFR(1), AD_PAF(1), o[0]); o[1] = AH_MFMA(AD_VFR(5), AD_PAF(1), o[1]);
  }
  const float ltot = l_reg + __shfl_xor(l_reg, 32);
  const float inv = 1.0f / ltot;
  bf16_t* dst = p.DILO + ((size_t)c * T_TOK + tok) * 384 + hd * 64;
  if (hi == 0) p.LSE2[((size_t)c * T_TOK + tok) * 6 + hd] = mhat + __builtin_amdgcn_logf(ltot);
#pragma unroll
  for (int dt = 0; dt < 2; ++dt)
#pragma unroll
    for (int gq = 0; gq < 4; ++gq) {
      uint2 ov;
      ov.x = pack2(o[dt][4 * gq + 0] * inv, o[dt][4 * gq + 1] * inv);
      ov.y = pack2(o[dt][4 * gq + 2] * inv, o[dt][4 * gq + 3] * inv);
      *(uint2*)(dst + 32 * dt + 8 * gq + 4 * hi) = ov;
    }
  asm volatile("s_waitcnt lgkmcnt(0)\n\ts_barrier" ::: "memory");
}

DI void attn_mem_resident(const int tid_, const Params& p, char* lds, int b, int hd, int m_first, int NQ) {
  const int tid = tid_, lane = tid & 63, r32 = lane & 31, hi = lane >> 5;
  const int wid = __builtin_amdgcn_readfirstlane(tid >> 6);
  const size_t tb = (size_t)b * SEQ;
  const bf16_t* Q = p.QKV + ((size_t)(36 + hd) * T_TOK + tb) * 64;
  const char* Kc = (const char*)(p.KVM + ((size_t)hd * (NB * MEMLEN) + (size_t)b * MEMLEN) * 64);
  const char* Vc = (const char*)(p.KVM + ((size_t)(4 + hd) * (NB * MEMLEN) + (size_t)b * MEMLEN) * 64);
  constexpr float slope2 = 0.f;
  constexpr int AD_KCH2 = 8192, AD_VDH = 16384, MEM_VB = 32768;
  constexpr int lb = 0;
  const unsigned lds0 = (unsigned)(size_t)lds;
  {
    const unsigned koff = (unsigned)(lane * 128 + wid * 16);
    const unsigned voff = (unsigned)((16 * (wid & 3) + (lane >> 2)) * 128 + (wid >> 2) * 64 + (lane & 3) * 16);
    const unsigned kdst = lds0 + wid * 4096, vdst = lds0 + MEM_VB + (wid >> 2) * 16384 + (wid & 3) * 1024;
#pragma unroll
    for (int i = 0; i < 4; ++i) {
      dma16_saddr(Kc + (size_t)i * 64 * 128, koff, kdst + i * 1024);
      dma16_saddr(Vc + (size_t)i * 64 * 128, voff, vdst + i * 4096);
    }
  }
  const ah_lds_cptr kp0 = (ah_lds_cptr)lds + hi * 4096 + r32 * 16;
  const ah_lds_cptr vp0 = (ah_lds_cptr)lds + MEM_VB + ((lane >> 4) & 1) * 32 + (lane & 3) * 8 + (4 * hi + ((lane & 15) >> 2)) * 64;
  const float qposh = 0.f;
  asm volatile("s_waitcnt vmcnt(0) lgkmcnt(0)\n\ts_barrier" ::: "memory");
#pragma unroll 1
  for (int qu = 0; qu < NQ; ++qu) {
    const int qrow = 256 * (m_first + qu) + wid * 32 + r32;
    bf16x8 qr[4];
#pragma unroll
    for (int d0 = 0; d0 < 4; ++d0) qr[d0] = *(const bf16x8*)(Q + (size_t)qrow * 64 + d0 * 16 + hi * 8);
    float mhat = 0.f, l_reg = 0.f, fres = 1.f;
    f32x16 o[2];
#pragma unroll
    for (int i = 0; i < 16; ++i) { o[0][i] = 0.f; o[1][i] = 0.f; }
    bool resc = false;
    f32x16 pA0, pA1, pB0, pB1;
    bf16x8 kf[8];
    s16x4 vlo[8], vhi[8];
    u32x4 pw0, pw1, pw2, pw3;
#pragma unroll
    for (int d0 = 0; d0 < 4; ++d0) ad_kload2<AD_KCH2>(kf, kp0, d0);
    AD_INIT(pA0, 0, 0, 0.f); AD_INIT(pA1, 0, 32, 0.f);
    pA0 = AH_MFMA(kf[0], qr[0], pA0); pA1 = AH_MFMA(kf[1], qr[0], pA1); pA0 = AH_MFMA(kf[2], qr[1], pA0); pA1 = AH_MFMA(kf[3], qr[1], pA1);
    pA0 = AH_MFMA(kf[4], qr[2], pA0); pA1 = AH_MFMA(kf[5], qr[2], pA1); pA0 = AH_MFMA(kf[6], qr[3], pA0); pA1 = AH_MFMA(kf[7], qr[3], pA1);
    {
      mhat = ah_rowmax(pA0, pA1);
      const float nm0 = -mhat;
#pragma unroll
      for (int r = 0; r < 16; ++r) { pA0[r] = __builtin_amdgcn_exp2f(pA0[r] + nm0); pA1[r] = __builtin_amdgcn_exp2f(pA1[r] + nm0); }
    }
#pragma unroll
    for (int d0 = 0; d0 < 4; ++d0) ad_kload2<AD_KCH2>(kf, kp0 + 1024, d0);
    AD_STEP(pB0, pB1, pA0, pA1, 1, false, true); AD_RESC();
    AD_STEP(pA0, pA1, pB0, pB1, 2, false, true); AD_RESC();
    AD_STEP(pB0, pB1, pA0, pA1, 3, false, false); AD_RESC();
    {
      float sacc = pB0[0] + pB0[1];
#pragma unroll
      for (int r = 2; r < 16; ++r) sacc += pB0[r];
#pragma unroll
      for (int r = 0; r < 16; ++r) sacc += pB1[r];
      l_reg += sacc;
      pw0 = (u32x4){AD_PKW(pB0, 0), AD_PKW(pB0, 2), AD_PKW(pB0, 4), AD_PKW(pB0, 6)}; pw1 = (u32x4){AD_PKW(pB0, 8), AD_PKW(pB0, 10), AD_PKW(pB0, 12), AD_PKW(pB0, 14)};
      pw2 = (u32x4){AD_PKW(pB1, 0), AD_PKW(pB1, 2), AD_PKW(pB1, 4), AD_PKW(pB1, 6)}; pw3 = (u32x4){AD_PKW(pB1, 8), AD_PKW(pB1, 10), AD_PKW(pB1, 12), AD_PKW(pB1, 14)};
      const ah_lds_cptr vp_ = vp0 + 3 * 4096;
#pragma unroll
      for (int i = 0; i < 8; ++i) AD_VRD(i);
      o[0] = AH_MFMA(AD_VFR(0), AD_PAF(0), o[0]); o[1] = AH_MFMA(AD_VFR(4), AD_PAF(0), o[1]); o[0] = AH_MFMA(AD_VFR(1), AD_PAF(1), o[0]); o[1] = AH_MFMA(AD_VFR(5), AD_PAF(1), o[1]);
      o[0] = AH_MFMA(AD_VFR(2), AD_PAF(2), o[0]); o[1] = AH_MFMA(AD_VFR(6), AD_PAF(2), o[1]); o[0] = AH_MFMA(AD_VFR(3), AD_PAF(3), o[0]); o[1] = AH_MFMA(AD_VFR(7), AD_PAF(3), o[1]);
    }
    const float ltot = l_reg + __shfl_xor(l_reg, 32);
    const float inv = 1.0f / ltot;
    bf16_t* dst = p.HN + (tb + qrow) * DM + 768 + hd * 64;
#pragma unroll
    for (int dt = 0; dt < 2; ++dt)
#pragma unroll
      for (int gq = 0; gq < 4; ++gq) {
        uint2 ov;
        ov.x = pack2(o[dt][4 * gq + 0] * inv, o[dt][4 * gq + 1] * inv);
        ov.y = pack2(o[dt][4 * gq + 2] * inv, o[dt][4 * gq + 3] * inv);
        *(uint2*)(dst + 32 * dt + 8 * gq + 4 * hi) = ov;
      }
  }
  asm volatile("s_waitcnt lgkmcnt(0)\n\ts_barrier" ::: "memory");
#undef AD_INIT
#undef AD_RESC
#undef AD_PKW
#undef AD_PAF
#undef AD_VFR
#undef AD_VRD
#undef AD_KRD
#undef AD_GAPA
#undef AD_GAPB
#undef AD_MF
#undef AD_STEP
}

DI void phase_attn_mfma(const int tid_, const Params& p, int bid, int nblk, char* lds, int PARTS = 7) {
  const int x = bid & 7, j = bid >> 3, nb = nblk >> 3;
  const int n_moba = 12 * 16, n_dil = 12 * 48;
  (void)PARTS;
  for (int k = 0; k * nb < n_moba; ++k) {
    int mb, mh, m;
    if (nb == 32) {
      const int tk = k % 3;
      int R = j;
      if (tk == 1) { const unsigned long long sg = 0xE0DA7659843B21CFull; R = (j < 16) ? (int)((sg >> (4 * j)) & 15) : 31 - (int)((sg >> (4 * (31 - j))) & 15); }
      const int r = (k < 3) ? R : 31 - R;
      int hs;
      if (tk == 2) { hs = r & 1; m = r >> 1; }
      else if (tk == 1) { if (r < 18) { hs = r & 1; m = r >> 1; } else if (r < 25) { hs = 0; m = r - 9; } else { hs = 1; m = r - 16; } }
      else { if (r < 4) { hs = r & 1; m = r >> 1; } else if (r < 18) { hs = 0; m = r - 2; } else { hs = 1; m = r - 16; } }
      mb = 2 * x + k / 3; mh = 2 * tk + hs;
    } else {
      const int li = k * nb + ((k & 1) ? (nb - 1 - j) : j);
      if (li >= n_moba) continue;
      const int bh = (li >> 4) * 8 + x;
      m = 15 - (li & 15); mb = bh / 6; mh = bh % 6;
    }
    int tq = tid_; asm volatile("" : "+v"(tq));
    attn_unit_hi<2>(tq, p, lds, mb, mh, m);
  }
  for (int si = bid; si < NB * 4 * 4; si += nblk) {
    const int jj = si >> 3, pair = (jj >> 2) * 8 + (si & 7);
    int tm = tid_; asm volatile("" : "+v"(tm));
    attn_mem_resident(tm, p, lds, pair >> 2, pair & 3, 4 * (jj & 3), 4);
  }
  for (int k = 0; k * nb < n_dil; ++k) {
    const int it = k * nb + ((k & 1) ? (nb - 1 - j) : j);
    if (it >= n_dil) continue;
    const int q = it % 48, bh = (it / 48) * 8 + x;
    int c, m, res;
    if (q < 16) { c = 0; m = q; res = 0; }
    else if (q < 32) { c = 1; m = (q - 16) & 3; res = (q - 16) >> 2; }
    else { c = 2; m = 0; res = q - 32; }
    int td = tid_; asm volatile("" : "+v"(td));
    attn_unit_dil(td, p, lds, bh / 6, bh % 6, m, c, res);
  }
}

DI void groupnorm_rows(const int tid_, const Params& p, int row0, int nrows, int gw, int nw) {
  const int lane = tid_ & 63;
  const int grp = lane < 24 ? 0 : (lane < 48 ? 1 : 2);
  const float* gp = grp == 0 ? p.og_dil + lane * 16 : (grp == 1 ? p.og_moba + (lane - 24) * 16 : p.og_mem + (lane - 48) * 16);
  const float inv_n = grp == 2 ? 1.0f / 256.0f : 1.0f / 384.0f;
  for (int row = row0 + gw; row < row0 + nrows; row += 4 * nw) {
    uint4 ya[4], yb[4], da[4][3], db[4][3];
    float ls[4][3];
#pragma unroll
    for (int u = 0; u < 4; ++u) {
      const int ru = min(row + u * nw, row0 + nrows - 1);
      const bf16_t* yp = p.HN + (size_t)ru * DM + lane * 16;
      if (grp == 0) {
#pragma unroll
        for (int c = 0; c < 3; ++c) {
          ls[u][c] = p.LSE2[((size_t)c * T_TOK + ru) * 6 + (lane >> 2)];
          const bf16_t* dp = p.DILO + ((size_t)c * T_TOK + ru) * 384 + lane * 16;
          da[u][c] = ((const uint4*)dp)[0]; db[u][c] = ((const uint4*)dp)[1];
        }
      } else {
        ya[u] = ((const uint4*)yp)[0]; yb[u] = ((const uint4*)yp)[1];
      }
    }
    __builtin_amdgcn_sched_barrier(0);
#pragma unroll
    for (int u = 0; u < 4; ++u) {
      bf16_t* yp = p.HN + (size_t)min(row + u * nw, row0 + nrows - 1) * DM + lane * 16;
      float v[16];
      if (grp == 0) {
        const float M = fmaxf(ls[u][0], fmaxf(ls[u][1], ls[u][2]));
        float wc[3], wsum = 0.f;
#pragma unroll
        for (int c = 0; c < 3; ++c) { wc[c] = __builtin_amdgcn_exp2f(ls[u][c] - M); wsum += wc[c]; }
        const float winv = 1.0f / wsum;
#pragma unroll
        for (int j = 0; j < 16; ++j) v[j] = 0.f;
#pragma unroll
        for (int c = 0; c < 3; ++c) {
          const unsigned dw[8] = {da[u][c].x, da[u][c].y, da[u][c].z, da[u][c].w, db[u][c].x, db[u][c].y, db[u][c].z, db[u][c].w};
          const float wgt = wc[c] * winv;
#pragma unroll
          for (int j = 0; j < 8; ++j) { v[2 * j] += wgt * __uint_as_float(dw[j] << 16); v[2 * j + 1] += wgt * __uint_as_float(dw[j] & 0xffff0000u); }
        }
      } else {
        const unsigned w[8] = {ya[u].x, ya[u].y, ya[u].z, ya[u].w, yb[u].x, yb[u].y, yb[u].z, yb[u].w};
#pragma unroll
        for (int j = 0; j < 8; ++j) { v[2 * j] = __uint_as_float(w[j] << 16); v[2 * j + 1] = __uint_as_float(w[j] & 0xffff0000u); }
      }
      float ss = 0.f;
#pragma unroll
      for (int j = 0; j < 16; ++j) ss += v[j] * v[j];
      const float s0 = wave_sum(grp == 0 ? ss : 0.f), s1 = wave_sum(grp == 1 ? ss : 0.f), s2 = wave_sum(grp == 2 ? ss : 0.f);
      const float tot = grp == 0 ? s0 : (grp == 1 ? s1 : s2);
      const float rinv = rsqrtf(tot * inv_n + 1e-6f);
      unsigned o[8];
#pragma unroll
      for (int j = 0; j < 8; ++j) o[j] = pack2(v[2 * j] * rinv * gp[2 * j], v[2 * j + 1] * rinv * gp[2 * j + 1]);
      ((uint4*)yp)[0] = make_uint4(o[0], o[1], o[2], o[3]);
      ((uint4*)yp)[1] = make_uint4(o[4], o[5], o[6], o[7]);
    }
  }
}

DI unsigned f2key(float f) { const unsigned u = __float_as_uint(f); return u ^ ((unsigned)((int)u >> 31) | 0x80000000u); }
DI float key2f(unsigned k) { const unsigned u = (k & 0x80000000u) ? (k ^ 0x80000000u) : ~k; return __uint_as_float(u); }
DI void cex_desc(unsigned& a, unsigned& b) { const unsigned hi = a > b ? a : b, lo = a > b ? b : a; a = hi; b = lo; }
DI void sort16_desc(unsigned (&a)[16]) {
  cex_desc(a[0], a[13]); cex_desc(a[1], a[12]); cex_desc(a[2], a[15]); cex_desc(a[3], a[14]); cex_desc(a[4], a[8]); cex_desc(a[5], a[6]); cex_desc(a[7], a[11]); cex_desc(a[9], a[10]);
  cex_desc(a[0], a[5]); cex_desc(a[1], a[7]); cex_desc(a[2], a[9]); cex_desc(a[3], a[4]); cex_desc(a[6], a[13]); cex_desc(a[8], a[14]); cex_desc(a[10], a[15]); cex_desc(a[11], a[12]);
  cex_desc(a[0], a[1]); cex_desc(a[2], a[3]); cex_desc(a[4], a[5]); cex_desc(a[6], a[8]); cex_desc(a[7], a[9]); cex_desc(a[10], a[11]); cex_desc(a[12], a[13]); cex_desc(a[14], a[15]);
  cex_desc(a[0], a[2]); cex_desc(a[1], a[3]); cex_desc(a[4], a[10]); cex_desc(a[5], a[11]); cex_desc(a[6], a[7]); cex_desc(a[8], a[9]); cex_desc(a[12], a[14]); cex_desc(a[13], a[15]);
  cex_desc(a[1], a[2]); cex_desc(a[3], a[12]); cex_desc(a[4], a[6]); cex_desc(a[5], a[7]); cex_desc(a[8], a[10]); cex_desc(a[9], a[11]); cex_desc(a[13], a[14]);
  cex_desc(a[1], a[4]); cex_desc(a[2], a[6]); cex_desc(a[5], a[8]); cex_desc(a[7], a[10]); cex_desc(a[9], a[13]); cex_desc(a[11], a[14]);
  cex_desc(a[2], a[4]); cex_desc(a[3], a[6]); cex_desc(a[9], a[12]); cex_desc(a[11], a[13]);
  cex_desc(a[3], a[5]); cex_desc(a[6], a[8]); cex_desc(a[7], a[9]); cex_desc(a[10], a[12]);
  cex_desc(a[3], a[4]); cex_desc(a[5], a[6]); cex_desc(a[7], a[8]); cex_desc(a[9], a[10]); cex_desc(a[11], a[12]);
  cex_desc(a[6], a[7]); cex_desc(a[8], a[9]);
}
DI void bitonic_merge16_desc(unsigned (&a)[16]) {
#pragma unroll
  for (int j = 8; j >= 1; j >>= 1)
#pragma unroll
    for (int i = 0; i < 16; ++i) { const int l = i ^ j; if (l > i) cex_desc(a[i], a[l]); }
}
DI void merge_top16(unsigned (&L)[16], const unsigned (&S)[16]) {
#pragma unroll
  for (int i = 0; i < 16; ++i) L[i] = L[i] > S[15 - i] ? L[i] : S[15 - i];
  bitonic_merge16_desc(L);
}

DI void peerq_scores_topk(const int tid_, const char* SKl, const f32x16 (&acc)[4], unsigned (&L)[16]) {
  const int lane = tid_ & 63, r = lane & 31, h = lane >> 5;
  bf16x8 xf[4][2];
#pragma unroll
  for (int nt = 0; nt < 4; ++nt)
#pragma unroll
    for (int s2 = 0; s2 < 2; ++s2) {
      u32x4 pk;
#pragma unroll
      for (int j = 0; j < 4; ++j) pk[j] = pack2(acc[nt][8 * s2 + 2 * j], acc[nt][8 * s2 + 2 * j + 1]);
      xf[nt][s2] = __builtin_bit_cast(bf16x8, pk);
    }
#pragma unroll
  for (int j = 0; j < 16; ++j) L[j] = 0u;
#pragma unroll 1
  for (int kt = 0; kt < 4; ++kt) {
    f32x16 sc;
#pragma unroll
    for (int i = 0; i < 16; ++i) sc[i] = 0.f;
    const char* krow = SKl + (32 * kt + r) * 256;
    const int ksw = r & 15;
#pragma unroll
    for (int nt = 0; nt < 4; ++nt)
#pragma unroll
      for (int s2 = 0; s2 < 2; ++s2) {
        const u32x4 kk = *(const u32x4*)(krow + ((((nt * 2 + s2) * 2 + h) ^ ksw) << 4));
        sc = __builtin_amdgcn_mfma_f32_32x32x16_bf16(__builtin_bit_cast(bf16x8, kk), xf[nt][s2], sc, 0, 0, 0);
      }
    unsigned S[16];
#pragma unroll
    for (int i = 0; i < 16; ++i) {
      const unsigned idx = (unsigned)(32 * kt + (i & 3) + 8 * (i >> 2) + 4 * h);
      S[i] = (f2key(sc[i]) & 0xffffff80u) | idx;
    }
    sort16_desc(S);
    if (kt == 0) {
#pragma unroll
      for (int j = 0; j < 16; ++j) L[j] = S[j];
    } else merge_top16(L, S);
  }
  unsigned P[16];
#pragma unroll
  for (int j = 0; j < 16; ++j) {
    auto rr = __builtin_amdgcn_permlane32_swap(L[j], L[j], false, false);
    L[j] = rr[0]; P[j] = rr[1];
  }
  merge_top16(L, P);
}

DI void peerq_item(const int tid_, const Params& p, char* lds, int mt, int head) {
  const int tid = tid_, lane = tid & 63, w = tid >> 6, r = lane & 31, h = lane >> 5;
  f32x16 acc[8];
#pragma unroll
  for (int a = 0; a < 8; ++a)
#pragma unroll
    for (int i = 0; i < 16; ++i) acc[a][i] = 0.f;
  unsigned loff[4];
#pragma unroll
  for (int j = 0; j < 4; ++j) {
    const int row = 32 * w + 8 * j + (lane >> 3);
    loff[j] = (unsigned)((row * DM + (((lane & 7) ^ ((row >> 1) & 7)) << 3)) * 2);
  }
  const int wave_s = __builtin_amdgcn_readfirstlane(w);
  const unsigned lds0 = (unsigned)(size_t)lds + (unsigned)(wave_s * 32 * 128);
  const char* Ab = (const char*)(p.HN + (size_t)(mt * 256) * DM);
  const char* Bb = (const char*)(p.WqT + (size_t)(head * 256) * DM);
  asm volatile("s_waitcnt vmcnt(0)" ::: "memory");
  __syncthreads();
#pragma unroll
  for (int j = 0; j < 4; ++j) { dma16_saddr(Ab, loff[j], lds0 + j * 1024); dma16_saddr(Bb, loff[j], lds0 + 32768 + j * 1024); }
  const unsigned sk_lds = (unsigned)(size_t)lds + (unsigned)(wave_s * 4096);
  {
    int l2 = lane; asm volatile("" : "+v"(l2));
    const bf16_t* sub1 = karg()->SUB1;
#pragma unroll
    for (int j = 0; j < 4; ++j) {
      const int pc = (wave_s * 4 + j) * 64 + l2, row = pc >> 4;
      dma16_saddr(sub1 + (size_t)head * 128 * 128, (unsigned)(row * 256 + (((pc & 15) ^ (row & 15)) << 4)), sk_lds + 2 * BIG_STAGE_BYTES + j * 1024);
    }
  }
  const int trow = 32 * w + r;
  const int toff = trow * 128, tsw = (trow >> 1) & 7, wsw = (r >> 1) & 7;
  for (int kt = 0; kt < 16; ++kt) {
    asm volatile("s_waitcnt vmcnt(0) lgkmcnt(0)" ::: "memory");
    __builtin_amdgcn_s_barrier();
    const char* Sc = lds + (kt & 1) * BIG_STAGE_BYTES;
    const unsigned ldn = lds0 + (unsigned)(((kt + 1) & 1) * BIG_STAGE_BYTES);
    const bool more = kt + 1 < 16;
    const char* An = Ab + (size_t)(kt + 1) * 128;
    const char* Bn = Bb + (size_t)(kt + 1) * 128;
#pragma unroll
    for (int s = 0; s < 4; ++s) {
      const bf16x8 tf = *(const bf16x8*)(Sc + toff + (((2 * s + h) ^ tsw) << 4));
      bf16x8 wf[4], wg[4];
#pragma unroll
      for (int nt = 0; nt < 4; ++nt) wf[nt] = *(const bf16x8*)(Sc + 32768 + (32 * nt + r) * 128 + (((2 * s + h) ^ wsw) << 4));
      if (more && s < 2) {
        dma16_saddr(An, loff[2 * s], ldn + (2 * s) * 1024); dma16_saddr(Bn, loff[2 * s], ldn + 32768 + (2 * s) * 1024);
        dma16_saddr(An, loff[2 * s + 1], ldn + (2 * s + 1) * 1024); dma16_saddr(Bn, loff[2 * s + 1], ldn + 32768 + (2 * s + 1) * 1024);
      }
#pragma unroll
      for (int nt = 0; nt < 4; ++nt) wg[nt] = *(const bf16x8*)(Sc + 32768 + (32 * (nt + 4) + r) * 128 + (((2 * s + h) ^ wsw) << 4));
#pragma unroll
      for (int nt = 0; nt < 4; ++nt) acc[nt] = __builtin_amdgcn_mfma_f32_32x32x16_bf16(wf[nt], tf, acc[nt], 0, 0, 0);
#pragma unroll
      for (int nt = 0; nt < 4; ++nt) acc[nt + 4] = __builtin_amdgcn_mfma_f32_32x32x16_bf16(wg[nt], tf, acc[nt + 4], 0, 0, 0);
      __builtin_amdgcn_sched_barrier(0);
    }
  }
  __syncthreads();
  {
    int l2 = lane; asm volatile("" : "+v"(l2));
    const bf16_t* sub2 = karg()->SUB2;
#pragma unroll
    for (int j = 0; j < 4; ++j) {
      const int pc = (wave_s * 4 + j) * 64 + l2, row = pc >> 4;
      dma16_saddr(sub2 + (size_t)head * 128 * 128, (unsigned)(row * 256 + (((pc & 15) ^ (row & 15)) << 4)), sk_lds + BIG_STAGE_BYTES + j * 1024);
    }
  }
  unsigned L0[16], L[16];
  {
    const f32x16 (&a0)[4] = *(const f32x16 (*)[4])&acc[0];
    peerq_scores_topk(tid_, lds + 2 * BIG_STAGE_BYTES, a0, L0);
    asm volatile("s_waitcnt vmcnt(0)" ::: "memory");
    __syncthreads();
    const f32x16 (&a1)[4] = *(const f32x16 (*)[4])&acc[4];
    peerq_scores_topk(tid_, lds + BIG_STAGE_BYTES, a1, L);
  }
  unsigned* stash0 = (unsigned*)lds + (32 * w + r) * 64 + 32 * h;
  unsigned* stash1 = stash0 + 16;
#pragma unroll
  for (int j = 0; j < 4; ++j) {
    *(u32x4*)(stash0 + 4 * j) = (u32x4){L0[4 * j], L0[4 * j + 1], L0[4 * j + 2], L0[4 * j + 3]};
    *(u32x4*)(stash1 + 4 * j) = (u32x4){L[4 * j], L[4 * j + 1], L[4 * j + 2], L[4 * j + 3]};
  }
  {
    float v1[16], v2[16];
#pragma unroll
    for (int j = 0; j < 16; ++j) { v1[j] = key2f(L0[j] & 0xffffff80u); v2[j] = key2f(L[j] & 0xffffff80u); }
    unsigned F[16], G[16];
#pragma unroll
    for (int b = 0; b < 16; ++b) F[b] = (f2key(v1[0] + v2[b]) & 0xffffff00u) | (unsigned)(15 - b);
#pragma unroll
    for (int grp = 1; grp < 3; ++grp) {
      int cnt = 0;
#pragma unroll
      for (int a = 0; a < 16; ++a)
#pragma unroll
        for (int b = 0; b < 16; ++b)
          if ((a + 1) * (b + 1) <= 16) {
            if ((cnt >> 4) == grp) G[cnt & 15] = (f2key(v1[a] + v2[b]) & 0xffffff00u) | (unsigned)(a * 16 + 15 - b);
            ++cnt;
          }
      sort16_desc(G);
      merge_top16(F, G);
    }
    {
      const unsigned k48 = (f2key(v1[14] + v2[0]) & 0xffffff00u) | (unsigned)(14 * 16 + 15);
      const unsigned k49 = (f2key(v1[15] + v2[0]) & 0xffffff00u) | (unsigned)(15 * 16 + 15);
      const unsigned khi = k48 > k49 ? k48 : k49, klo = k48 > k49 ? k49 : k48;
      F[15] = F[15] > khi ? F[15] : khi;
      F[14] = F[14] > klo ? F[14] : klo;
    }
    const float mx = key2f(F[0] & 0xffffff00u);
    float e[16], den = 0.f;
    int ex[16];
#pragma unroll
    for (int j = 0; j < 16; ++j) {
      e[j] = __expf(key2f(F[j] & 0xffffff00u) - mx);
      den += e[j];
      const int a = (F[j] >> 4) & 15, b = 15 - (int)(F[j] & 15);
      const unsigned k1 = stash0[a], k2 = stash1[b];
      ex[j] = (int)((k1 & 127u) * 128u + (k2 & 127u));
    }
    const float inv = 1.0f / den;
    if (h == 0) {
      const size_t o = (size_t)(mt * 256 + 32 * w + r) * 128 + head * 16;
#pragma unroll
      for (int j = 0; j < 2; ++j)
        *(u32x4*)(p.PIDX + o + 8 * j) = (u32x4){(unsigned)ex[8 * j] | ((unsigned)ex[8 * j + 1] << 16), (unsigned)ex[8 * j + 2] | ((unsigned)ex[8 * j + 3] << 16),
                                                (unsigned)ex[8 * j + 4] | ((unsigned)ex[8 * j + 5] << 16), (unsigned)ex[8 * j + 6] | ((unsigned)ex[8 * j + 7] << 16)};
#pragma unroll
      for (int j = 0; j < 4; ++j)
        *(float4*)(p.PGATE + o + 4 * j) = make_float4(e[4 * j] * inv, e[4 * j + 1] * inv, e[4 * j + 2] * inv, e[4 * j + 3] * inv);
    }
  }
}

template <int CTRL>
DI int dpp_addi(int v) { return v + __builtin_amdgcn_update_dpp(0, v, CTRL, 0xf, 0xf, true); }
DI void phase_peer_u(const int tid_, const Params& p, int bid, int nblk) {
  const int lane = tid_ & 63, w = tid_ >> 6, g = lane >> 3, l8 = lane & 7;
  const int k = bid & 7, ws = (bid >> 3) * WPB + w, nws = (nblk >> 3) * WPB;
  const uint8_t* Us = p.U8s + (size_t)k * 16384 * 128;
  const unsigned lo16 = 16u * (unsigned)l8;
  bf16_t* PPk = (bf16_t*)p.PP + (size_t)k * T_TOK * 128;
  for (int G = ws; G < T_TOK / 8; G += nws) {
    const int t = 8 * G + g;
    const u32x4 xq = *(const u32x4*)(p.X8 + ((size_t)k * T_TOK + t) * 128 + 16 * l8);
    const float sx = p.SX[(size_t)t * 8 + k];
    const unsigned short* ip = p.PIDX + (size_t)t * 128;
    u32x4 qi[16];
#pragma unroll
    for (int j = 0; j < 16; ++j) qi[j] = *(const u32x4*)(ip + 8 * j);
#pragma unroll
    for (int c = 0; c < 8; ++c) {
      int idx[16];
#pragma unroll
      for (int j = 0; j < 2; ++j) {
        const u32x4 q = qi[2 * c + j];
#pragma unroll
        for (int e = 0; e < 4; ++e) { idx[8 * j + 2 * e] = (int)(q[e] & 0xffffu); idx[8 * j + 2 * e + 1] = (int)(q[e] >> 16); }
      }
      u32x4 u[16];
#pragma unroll
      for (int i = 0; i < 16; ++i) u[i] = *(const u32x4*)(Us + (((unsigned)idx[i] << 7) + lo16));
      int o0 = 0, o1 = 0;
#pragma unroll
      for (int i = 0; i < 16; ++i) {
        int acc = 0;
#pragma unroll
        for (int d = 0; d < 4; ++d) acc = __builtin_amdgcn_sdot4((int)u[i][d], (int)xq[d], acc, false);
        acc = dpp_addi<0xB1>(acc);
        acc = dpp_addi<0x4E>(acc);
        acc = dpp_addi<0x141>(acc);
        if ((i >> 1) == l8) { if (i & 1) o1 = acc; else o0 = acc; }
      }
      *(unsigned*)(PPk + (size_t)t * 128 + 16 * c + 2 * l8) = pack2((float)o0 * sx, (float)o1 * sx);
    }
  }
}

DI void phase_peer_w(const int tid_, const Params& p, int bid, int nblk) {
  const int gt = bid * NTHREADS + tid_, nt = nblk * NTHREADS;
  const int total = T_TOK * 128 / 4;
  for (int i0 = gt; i0 < total; i0 += 4 * nt) {
    uint2 pq[4][8], ei[4];
    float4 gte[4];
    int ii[4];
#pragma unroll
    for (int u = 0; u < 4; ++u) {
      ii[u] = min(i0 + u * nt, total - 1);
#pragma unroll
      for (int k = 0; k < 8; ++k) pq[u][k] = ((const uint2*)((const bf16_t*)p.PP + (size_t)k * T_TOK * 128))[ii[u]];
      gte[u] = ((const float4*)p.PGATE)[ii[u]];
      ei[u] = ((const uint2*)p.PIDX)[ii[u]];
    }
    __builtin_amdgcn_sched_barrier(0);
    float su[4][4], sv[4][4];
#pragma unroll
    for (int u = 0; u < 4; ++u) {
      const int e4[4] = {(int)(ei[u].x & 0xffffu), (int)(ei[u].x >> 16), (int)(ei[u].y & 0xffffu), (int)(ei[u].y >> 16)};
#pragma unroll
      for (int j = 0; j < 4; ++j) { su[u][j] = p.SU[e4[j]]; sv[u][j] = p.SV[e4[j]]; }
    }
    __builtin_amdgcn_sched_barrier(0);
#pragma unroll
    for (int u = 0; u < 4; ++u) {
      float4 s = make_float4(0.f, 0.f, 0.f, 0.f);
#pragma unroll
      for (int k = 0; k < 8; ++k) {
        const uint2 q = pq[u][k];
        s.x += __uint_as_float(q.x << 16); s.y += __uint_as_float(q.x & 0xffff0000u);
        s.z += __uint_as_float(q.y << 16); s.w += __uint_as_float(q.y & 0xffff0000u);
      }
      float a[4] = {s.x, s.y, s.z, s.w}, gg[4] = {gte[u].x, gte[u].y, gte[u].z, gte[u].w}, o[4];
      float mx = 0.f;
#pragma unroll
      for (int j = 0; j < 4; ++j) {
        const float v = a[j] * su[u][j];
        o[j] = 0.5f * v * (1.0f + erff(v * 0.70710678118654752f)) * gg[j] * sv[u][j];
        mx = fmaxf(mx, fabsf(o[j]));
      }
      mx = max32(mx);
      const float inv = mx > 0.f ? 127.0f / mx : 0.f;
      const unsigned q = ((unsigned)__float2int_rn(o[0] * inv) & 0xffu) | (((unsigned)__float2int_rn(o[1] * inv) & 0xffu) << 8) |
                         (((unsigned)__float2int_rn(o[2] * inv) & 0xffu) << 16) | (((unsigned)__float2int_rn(o[3] * inv) & 0xffu) << 24);
      const int i = ii[u], t = i >> 5;
      if (i0 + u * nt < total) {
        ((unsigned*)(p.PGATE + (size_t)t * 128))[i & 31] = q;
        if ((i & 31) == 0) p.SW[t] = mx * (1.0f / 127.0f);
      }
    }
  }
}

DI unsigned perm_b32(unsigned hi, unsigned lo, unsigned sel) { return __builtin_amdgcn_perm(hi, lo, sel); }
DI void phase_peer_v(const int tid_, const Params& p, int bid, int nblk) {
  const int lane = tid_ & 63, w = tid_ >> 6, g = lane >> 3, l8 = lane & 7;
  const int k = bid & 7, ws = (bid >> 3) * WPB + w, nws = (nblk >> 3) * WPB;
  const uint8_t* Vs = p.V8s + (size_t)k * 16384 * 128;
  const unsigned lo16 = 16u * (unsigned)l8;
  for (int G = ws; G < T_TOK / 8; G += nws) {
    const int t = 8 * G + g;
    const unsigned short* ip = p.PIDX + (size_t)t * 128;
    const unsigned* wq = (const unsigned*)(p.PGATE + (size_t)t * 128);
    const float sw = p.SW[t];
    int acc[16];
#pragma unroll
    for (int j = 0; j < 16; ++j) acc[j] = 0;
    const u32x4* xp = (const u32x4*)(X1B(p) + (size_t)t * DM + 128 * k + 16 * l8);
    const u32x4 xa = xp[0], xb = xp[1];
    u32x4 qi[16], w4a[8];
#pragma unroll
    for (int j = 0; j < 16; ++j) qi[j] = *(const u32x4*)(ip + 8 * j);
#pragma unroll
    for (int j = 0; j < 8; ++j) w4a[j] = *(const u32x4*)(wq + 4 * j);
#pragma unroll
    for (int c = 0; c < 8; ++c) {
      int idx[16];
#pragma unroll
      for (int j = 0; j < 2; ++j) {
        const u32x4 q = qi[2 * c + j];
#pragma unroll
        for (int e = 0; e < 4; ++e) { idx[8 * j + 2 * e] = (int)(q[e] & 0xffffu); idx[8 * j + 2 * e + 1] = (int)(q[e] >> 16); }
      }
      const u32x4 w4 = w4a[c];
      u32x4 v[16];
#pragma unroll
      for (int i = 0; i < 16; ++i) v[i] = *(const u32x4*)(Vs + (((unsigned)idx[i] << 7) + lo16));
#pragma unroll
      for (int q4 = 0; q4 < 4; ++q4) {
#pragma unroll
        for (int d = 0; d < 4; ++d) {
          const unsigned x0 = v[4 * q4][d], x1 = v[4 * q4 + 1][d], x2 = v[4 * q4 + 2][d], x3 = v[4 * q4 + 3][d];
          const unsigned t01l = perm_b32(x1, x0, 0x05010400u);
          const unsigned t01h = perm_b32(x1, x0, 0x07030602u);
          const unsigned t23l = perm_b32(x3, x2, 0x05010400u);
          const unsigned t23h = perm_b32(x3, x2, 0x07030602u);
          const unsigned y0 = perm_b32(t23l, t01l, 0x05040100u);
          const unsigned y1 = perm_b32(t23l, t01l, 0x07060302u);
          const unsigned y2 = perm_b32(t23h, t01h, 0x05040100u);
          const unsigned y3 = perm_b32(t23h, t01h, 0x07060302u);
          acc[4 * d + 0] = __builtin_amdgcn_sdot4((int)y0, (int)w4[q4], acc[4 * d + 0], false);
          acc[4 * d + 1] = __builtin_amdgcn_sdot4((int)y1, (int)w4[q4], acc[4 * d + 1], false);
          acc[4 * d + 2] = __builtin_amdgcn_sdot4((int)y2, (int)w4[q4], acc[4 * d + 2], false);
          acc[4 * d + 3] = __builtin_amdgcn_sdot4((int)y3, (int)w4[q4], acc[4 * d + 3], false);
        }
      }
    }
    float4* op = (float4*)(p.out + (size_t)t * DM + 128 * k + 16 * l8);
    const unsigned xw[8] = {xa[0], xa[1], xa[2], xa[3], xb[0], xb[1], xb[2], xb[3]};
#pragma unroll
    for (int j = 0; j < 4; ++j) {
      float4 o;
      o.x = __uint_as_float(xw[2 * j] << 16) + sw * (float)acc[4 * j];
      o.y = __uint_as_float(xw[2 * j] & 0xffff0000u) + sw * (float)acc[4 * j + 1];
      o.z = __uint_as_float(xw[2 * j + 1] << 16) + sw * (float)acc[4 * j + 2];
      o.w = __uint_as_float(xw[2 * j + 1] & 0xffff0000u) + sw * (float)acc[4 * j + 3];
      op[j] = o;
    }
  }
}

#define XB_TMO      128
#define XB_XCNT(j)  (256  + 64 * (j))
#define XB_XSUB(j)  (1280 + 64 * (j))
#define XB_XGEN(j)  (2304 + 64 * (j))
#define XB_TOP      3328
#define XB_TOPGEN   3392
#define XCD_BAR_WORDS 3456
#define XB_SPIN_CAP (1u << 20)
#define LAS __attribute__((address_space(3)))
DI unsigned xb_ld(unsigned* p) { return __hip_atomic_load(p, __ATOMIC_RELAXED, __HIP_MEMORY_SCOPE_AGENT); }
DI unsigned xb_add(unsigned* p, unsigned v) { return __hip_atomic_fetch_add(p, v, __ATOMIC_RELAXED, __HIP_MEMORY_SCOPE_AGENT); }
DI unsigned xb_xcc_id() { return (unsigned)__builtin_amdgcn_s_getreg((3 << 11) | 20) & 0xFu; }
#define XB_SPIN(cond, bar) do { unsigned _sp = 0; while (cond) { __builtin_amdgcn_s_sleep(1); \
    if ((++_sp & 255u) == 0u) { if (xb_ld(&(bar)[XB_TMO])) break; if (_sp > XB_SPIN_CAP) { atomicAdd(&(bar)[XB_TMO], 1u); break; } } } } while (0)
struct XcdBarrier { unsigned packed; };
DI XcdBarrier xcd_barrier_post(const int tid_, unsigned* bar) {
  XcdBarrier b; b.packed = xb_xcc_id();
  if (tid_ == 0) (void)xb_add(&bar[XB_XCNT(b.packed)], 1u);
  return b;
}
DI void xcd_barrier_complete(unsigned* bar, unsigned x, unsigned& nloc, unsigned& nx) {
  const unsigned G = gridDim.x * gridDim.y * gridDim.z;
  unsigned sum, cnt, mine, sp = 0u;
  for (;;) {
    sum = 0u; cnt = 0u; mine = 0u;
#pragma unroll
    for (unsigned j = 0; j < 16; ++j) { const unsigned c = xb_ld(&bar[XB_XCNT(j)]); sum += c; cnt += (c > 0u) ? 1u : 0u; mine = (j == x) ? c : mine; }
    if (sum == G) break;
    __builtin_amdgcn_s_sleep(1);
    if ((++sp & 255u) == 0u) { if (xb_ld(&bar[XB_TMO])) break; if (sp > XB_SPIN_CAP) { atomicAdd(&bar[XB_TMO], 1u); break; } }
  }
  nloc = mine > 0u ? mine : 1u; nx = cnt > 0u ? cnt : 1u;
}
DI void xcd_barrier(const int tid_, XcdBarrier& b) {
  unsigned* bar = karg()->bar;
  asm volatile("s_waitcnt vmcnt(0)" ::: "memory");
  __syncthreads();
  if ((b.packed >> 9) == 0u) {
    unsigned nl, nxx;
    xcd_barrier_complete(bar, b.packed & 15u, nl, nxx);
    b.packed = (unsigned)__builtin_amdgcn_readfirstlane((int)((b.packed & 15u) | (nxx << 4) | (nl << 9)));
  }
  if (tid_ == 0) {
    __builtin_amdgcn_s_waitcnt(0);
    const unsigned x = b.packed & 15u, nx = (b.packed >> 4) & 31u, nloc = b.packed >> 9;
    const unsigned old = xb_add(&bar[XB_XSUB(x)], 1u);
    const unsigned gen = old / nloc;
    if (old + 1u == (gen + 1u) * nloc) {
      __builtin_amdgcn_fence(__ATOMIC_RELEASE, "agent");
      asm volatile("s_waitcnt vmcnt(0)" ::: "memory");
      const unsigned og = xb_add(&bar[XB_TOP], 1u);
      const unsigned tg = og / nx;
      if (og + 1u == (tg + 1u) * nx) xb_add(&bar[XB_TOPGEN], 1u);
      else XB_SPIN(xb_ld(&bar[XB_TOPGEN]) == tg, bar);
      __builtin_amdgcn_fence(__ATOMIC_ACQUIRE, "agent");
      xb_add(&bar[XB_XGEN(x)], 1u);
      asm volatile("s_waitcnt vmcnt(0)" ::: "memory");
    } else {
      XB_SPIN(xb_ld(&bar[XB_XGEN(x)]) == gen, bar);
      __builtin_amdgcn_fence(__ATOMIC_ACQUIRE, "agent");
      asm volatile("s_waitcnt vmcnt(0)" ::: "memory");
    }
  }
  __syncthreads();
}

DI void norm2_rows(const int tid_, const Params& p, int row0, int nrows, int gw, int nw) {
  const int lane = tid_ & 63;
  float4 gg[4];
#pragma unroll
  for (int i = 0; i < 4; ++i) gg[i] = ((const float4*)p.g_ffn)[lane + 64 * i];
  for (int row = row0 + gw; row < row0 + nrows; row += 8 * nw) {
    uint2 q2[8][4];
#pragma unroll
    for (int u = 0; u < 8; ++u) {
      const uint2* s2 = (const uint2*)(X1B(p) + (size_t)min(row + u * nw, row0 + nrows - 1) * DM);
#pragma unroll
      for (int i = 0; i < 4; ++i) q2[u][i] = s2[lane + 64 * i];
    }
    __builtin_amdgcn_sched_barrier(0);
#pragma unroll
    for (int u = 0; u < 8; ++u) {
      const int ru = min(row + u * nw, row0 + nrows - 1);
      float4 v[4];
      float ss = 0.f;
#pragma unroll
      for (int i = 0; i < 4; ++i) {
        v[i] = make_float4(__uint_as_float(q2[u][i].x << 16), __uint_as_float(q2[u][i].x & 0xffff0000u), __uint_as_float(q2[u][i].y << 16), __uint_as_float(q2[u][i].y & 0xffff0000u));
        ss += v[i].x * v[i].x + v[i].y * v[i].y + v[i].z * v[i].z + v[i].w * v[i].w;
      }
      ss = wave_sum(ss);
      const float rinv = rsqrtf(ss * (1.0f / DM) + 1e-6f);
#pragma unroll
      for (int i = 0; i < 4; ++i) {
        const float a = v[i].x * rinv * gg[i].x, b = v[i].y * rinv * gg[i].y, c = v[i].z * rinv * gg[i].z, d = v[i].w * rinv * gg[i].w;
        uint2 o;
        o.x = pack2(a, b); o.y = pack2(c, d);
        ((uint2*)(p.HN + (size_t)ru * DM))[lane + 64 * i] = o;
        float mx = fmaxf(fmaxf(fabsf(a), fabsf(b)), fmaxf(fabsf(c), fabsf(d)));
        mx = max32(mx);
        const float inv = mx > 0.f ? 127.0f / mx : 0.f;
        const unsigned q = ((unsigned)__float2int_rn(a * inv) & 0xffu) | (((unsigned)__float2int_rn(b * inv) & 0xffu) << 8) |
                           (((unsigned)__float2int_rn(c * inv) & 0xffu) << 16) | (((unsigned)__float2int_rn(d * inv) & 0xffu) << 24);
        const int slice = 2 * i + (lane >> 5);
        *(unsigned*)(p.X8 + ((size_t)slice * T_TOK + ru) * 128 + 4 * (lane & 31)) = q;
        if ((lane & 31) == 0) p.SX[(size_t)ru * 8 + slice] = mx * (1.0f / 127.0f);
      }
    }
  }
}

DI void phase_post(const int tid_, const Params& p, int bid, int nblk, char* lds) {
  for (int mt = bid; mt < T_TOK / 256; mt += nblk) {
    int ta = tid_; asm volatile("" : "+v"(ta));
    groupnorm_rows(ta, p, mt * 256, 256, ta >> 6, WPB);
    asm volatile("s_waitcnt vmcnt(0)" ::: "memory");
    __syncthreads();
    int tb = tid_; asm volatile("" : "+v"(tb));
#pragma unroll 1
    for (int nt_ = 0; nt_ < 4 * PP_OUT; ++nt_) {
      const int nt = nt_ & 3;
      f32x16 acc[4][2];
      gemm_big(tb, p.HN, p.WoutT, DM, mt * 256, nt * 256, lds, acc);
#pragma unroll 1
      for (int pass = 0; pass < 2; ++pass) {
        gemm_big_dump(tb, acc, pass, lds);
        const float* Cs = (const float*)lds;
#pragma unroll 1
        for (int g8 = 0; g8 < 2; ++g8) {
          float4 xv[8];
#pragma unroll
          for (int u = 0; u < 8; ++u) {
            const int task = tb + NTHREADS * (8 * g8 + u);
            xv[u] = *(const float4*)(p.x + (size_t)(mt * 256 + (task >> 5)) * DM + nt * 256 + pass * 128 + (task & 31) * 4);
          }
          __builtin_amdgcn_sched_barrier(0);
#pragma unroll
          for (int u = 0; u < 8; ++u) {
            const int task = tb + NTHREADS * (8 * g8 + u);
            const int row = task >> 5, c4 = task & 31;
            const float4 c = *(const float4*)(Cs + row * 132 + c4 * 4);
            const size_t off = (size_t)(mt * 256 + row) * DM + nt * 256 + pass * 128 + c4 * 4;
            uint2 o2; o2.x = pack2(xv[u].x + c.x, xv[u].y + c.y); o2.y = pack2(xv[u].z + c.z, xv[u].w + c.w);
            *(uint2*)(X1B(p) + off) = o2;
          }
        }
      }
    }
    asm volatile("s_waitcnt vmcnt(0)" ::: "memory");
    __syncthreads();
    int tc = tid_; asm volatile("" : "+v"(tc));
#pragma unroll 1
    for (int rep_ = 0; rep_ < PP_N2; ++rep_) norm2_rows(tc, p, mt * 256, 256, tc >> 6, WPB);
    asm volatile("s_waitcnt vmcnt(0)" ::: "memory");
    __syncthreads();
#pragma unroll 1
    for (int head = 0; head < 8 * PP_PQ; ++head) { int td = tid_; asm volatile("" : "+v"(td)); peerq_item(td, p, lds, mt, head & 7); }
  }
}

#define NPHASE 7
template <int PH>
DI void run_phase(const int tid_, const Params& p, int bid, int nblk, char* lds, int parts = 7) {
  if (PH == 0) phase_prep(tid_, p, bid, nblk);
  if (PH == 1) phase_proj(tid_, p, bid, nblk, lds);
  if (PH == 2) phase_attn_mfma(tid_, p, bid, nblk, lds, parts);
  if (PH == 3) phase_post(tid_, p, bid, nblk, lds);
  if (PH == 4) phase_peer_u(tid_, p, bid, nblk);
  if (PH == 5) phase_peer_w(tid_, p, bid, nblk);
  if (PH == 6) phase_peer_v(tid_, p, bid, nblk);
}
template <int PH>
DI void mega_step(int bid, int nblk, char* lds, cg::grid_group& grid, XcdBarrier& xb, int wave_u) {
  unsigned z_ = 0u; asm volatile("" : "+v"(z_));
  int tid_ = wave_u * 64 + (int)__builtin_amdgcn_mbcnt_hi(~0u, __builtin_amdgcn_mbcnt_lo(~0u, z_));
  asm volatile("" : "+v"(tid_));
#if defined(__HIP_DEVICE_COMPILE__)
  KernargPtr pp = (KernargPtr)__builtin_amdgcn_kernarg_segment_ptr();
  asm volatile("" : "+s"(pp));
  const Params p = *pp;
#else
  const Params p{};
#endif
  if (DUP_PHASE == PH) {
    int nrep = 2; asm volatile("" : "+s"(nrep));
    for (int rep = 0; rep < nrep; ++rep) { if (rep) xcd_barrier(tid_, xb); run_phase<PH>(tid_, p, bid, nblk, lds, rep ? 7 : DUP_PARTS); }
  } else
#ifdef ONLY_PHASE
  if (PH == ONLY_PHASE)
#endif
  run_phase<PH>(tid_, p, bid, nblk, lds);
  if (PH == 0) {
    grid.sync();
    xb = xcd_barrier_post(tid_, karg()->bar);
  }
  else if (PH + 1 < NPHASE) xcd_barrier(tid_, xb);
}
__global__ void __launch_bounds__(NTHREADS, 2) mega(Params p0) {
  __shared__ __attribute__((aligned(16))) char lds[LDS_BYTES];
  const int bid = blockIdx.x, nblk = gridDim.x;
  cg::grid_group grid = cg::this_grid();
  const int tid_ = (int)__builtin_amdgcn_workitem_id_x();
  if (bid == 0) {
    for (int i = tid_; i < XCD_BAR_WORDS; i += NTHREADS) p0.bar[i] = 0u;
    __threadfence();
  }
  XcdBarrier xb; xb.packed = 0u;
  const int wave_u = __builtin_amdgcn_readfirstlane(tid_ >> 6);
  mega_step<0>(bid, nblk, lds, grid, xb, wave_u);
  mega_step<1>(bid, nblk, lds, grid, xb, wave_u);
  mega_step<2>(bid, nblk, lds, grid, xb, wave_u);
  mega_step<3>(bid, nblk, lds, grid, xb, wave_u);
  mega_step<4>(bid, nblk, lds, grid, xb, wave_u);
  mega_step<5>(bid, nblk, lds, grid, xb, wave_u);
  mega_step<6>(bid, nblk, lds, grid, xb, wave_u);
}

static inline size_t align_up(size_t v) { return (v + 255) & ~(size_t)255; }

extern "C" void kernel_launch(void* const* d_in, const int* in_sizes, int n_in, void* d_out, int out_size, void* d_ws,
                              size_t ws_size, hipStream_t stream) {
  Params p{};
  const float* const* in = (const float* const*)d_in;
  p.x = in[0]; p.mem = in[1]; p.g_mix = in[2]; p.w_in = in[3]; p.qg_dil = in[4]; p.kg_dil = in[5]; p.qg_moba = in[6];
  p.kg_moba = in[7]; p.qg_mem = in[8]; p.kg_mem = in[9]; p.g_memtok = in[10]; p.w_mem_kv = in[11]; p.og_dil = in[12];
  p.og_moba = in[13]; p.og_mem = in[14]; p.w_out = in[15]; p.g_ffn = in[16]; p.w_peer_q = in[17]; p.sub1 = in[18];
  p.sub2 = in[19]; p.peer_u = in[20]; p.peer_v = in[21];
  p.out = (float*)d_out;
  char* w = (char*)d_ws;
  size_t off = 0;
  auto take = [&](size_t bytes) { char* r = w + off; off = align_up(off + bytes); return r; };
  p.bar = (unsigned*)take((size_t)XCD_BAR_WORDS * 4);
  p.HN = (bf16_t*)take((size_t)T_TOK * DM * 2);
  p.QKV = (bf16_t*)take((size_t)NGRP * T_TOK * 64 * 2);
  p.MEMN = (bf16_t*)take((size_t)NB * MEMLEN * DM * 2);
  p.KVM = (bf16_t*)take((size_t)8 * NB * MEMLEN * 64 * 2);
  p.WinT = (bf16_t*)take((size_t)INW * DM * 2);
  p.WoutT = (bf16_t*)take((size_t)DM * DM * 2);
  p.WqT = (bf16_t*)take((size_t)2048 * DM * 2);
  p.WmkvT = (bf16_t*)take((size_t)512 * DM * 2);
  p.SUB1 = (bf16_t*)take((size_t)8 * 128 * 128 * 2);
  p.SUB2 = (bf16_t*)take((size_t)8 * 128 * 128 * 2);
  p.KMEAN = (float*)take((size_t)NB * 6 * 16 * 64 * 4);
  p.PIDX = (unsigned short*)take((size_t)T_TOK * 128 * 2);
  p.PGATE = (float*)take((size_t)T_TOK * 128 * 4);
  p.DILO = (bf16_t*)take((size_t)3 * T_TOK * 384 * 2);
  p.LSE2 = (float*)take((size_t)3 * T_TOK * 6 * 4);
  p.U8s = (uint8_t*)take((size_t)16384 * DM);
  p.V8s = (uint8_t*)take((size_t)16384 * DM);
  p.PP = (float*)p.QKV;
  p.SU = (float*)take((size_t)16384 * 4);
  p.SV = (float*)take((size_t)16384 * 4);
  p.SW = (float*)take((size_t)T_TOK * 4);
  p.X8 = (uint8_t*)p.DILO;
  p.SX = (float*)((char*)p.DILO + (size_t)T_TOK * DM);
  if (off > ws_size) { fprintf(stderr, "workspace too small: need %zu have %zu\n", off, ws_size); return; }

  static int grid_blocks = 0;
  if (!grid_blocks) {
    int dev = 0, cus = 0, per_cu = 0;
    (void)hipGetDevice(&dev);
    (void)hipDeviceGetAttribute(&cus, hipDeviceAttributeMultiprocessorCount, dev);
    (void)hipOccupancyMaxActiveBlocksPerMultiprocessor(&per_cu, mega, NTHREADS, 0);
    if (per_cu < 1) fprintf(stderr, "occupancy query says the kernel does not fit a CU\n");
    grid_blocks = cus & ~7;
  }
  void* args[] = {&p};
  hipError_t e = hipLaunchCooperativeKernel((void*)mega, dim3(grid_blocks), dim3(NTHREADS), args, 0, stream);
  if (e != hipSuccess) fprintf(stderr, "cooperative launch failed: %s (grid %d)\n", hipGetErrorString(e), grid_blocks);
}
```
